# Optimizing an MI355X kernel written in HIP

```python
import jax, jax.numpy as jnp
from jax import lax
import numpy as np

D_MODEL = 1024
BATCH = 32
SEQ = 2048
DEPTH = 2
DEC_BATCH = 16
DEC_SEQ = 16
PAST_LEN = 4096

CHUNK = 64
N_A_LAYERS = DEPTH // 2
N_B_LAYERS = DEPTH - N_A_LAYERS
LRU_WIDTH = D_MODEL
N_LRU_BLOCKS = 16
LRU_BLOCK = LRU_WIDTH // N_LRU_BLOCKS
LRU_CONV = 4
LRU_C = 8.0
N_HEADS = 8
HEAD_DIM = D_MODEL // N_HEADS
D_FF = 3 * D_MODEL
FFN_CONV = 3
Q_BLOCK = 128
EPS = 1e-6

kernel_name = 'hawk_stickbreak_yoco_stream_step'


def rmsnorm(x, g):
    xf = x.astype(jnp.float32)
    y = xf * lax.rsqrt(jnp.mean(xf * xf, axis=-1, keepdims=True) + EPS) * g.astype(jnp.float32)
    return y.astype(x.dtype)


def causal_dwconv(x, prev, w, b):
    width = w.shape[0]
    t_len = x.shape[1]
    xp = jnp.concatenate([prev.astype(x.dtype), x], axis=1)
    y = b
    for k in range(width):
        y = y + w[k] * xp[:, k:k + t_len]
    return y.astype(x.dtype), xp[:, xp.shape[1] - (width - 1):]


def linear_scan(a, b, h0):
    b = b.at[:, 0].add(a[:, 0] * h0)
    def comb(l, r):
        return (l[0] * r[0], r[0] * l[1] + r[1])
    _, h = lax.associative_scan(comb, (a, b), axis=1)
    return h


def rglru_mixer(x, h0, conv_prev, norm, w_in, conv_w, conv_b, wr, br, wi, bi, lam, w_out):
    bsz, t_len, _ = x.shape
    xn = rmsnorm(x, norm)
    gate_in, rec_in = jnp.split(xn @ w_in, 2, axis=-1)
    c, conv_new = causal_dwconv(rec_in, conv_prev, conv_w, conv_b)
    cb = c.reshape(bsz, t_len, N_LRU_BLOCKS, LRU_BLOCK)
    r = jax.nn.sigmoid(jnp.einsum('btnd,nde->btne', cb, wr).reshape(bsz, t_len, LRU_WIDTH) + br).astype(jnp.float32)
    i = jax.nn.sigmoid(jnp.einsum('btnd,nde->btne', cb, wi).reshape(bsz, t_len, LRU_WIDTH) + bi).astype(jnp.float32)
    log_a = LRU_C * r * jax.nn.log_sigmoid(lam.astype(jnp.float32))
    a = jnp.exp(log_a)
    bterm = jnp.sqrt(-jnp.expm1(2.0 * log_a)) * i * c.astype(jnp.float32)
    h = linear_scan(a, bterm, h0.astype(jnp.float32))
    y = (h.astype(x.dtype) * jax.nn.gelu(gate_in)) @ w_out
    return y, h[:, -1].astype(x.dtype), conv_new


def shared_kv(x, kv_norm, w_kv, k_norm):
    bsz, t_len, _ = x.shape
    k, v = jnp.split(rmsnorm(x, kv_norm) @ w_kv, 2, axis=-1)
    k = rmsnorm(k.reshape(bsz, t_len, N_HEADS, HEAD_DIM), k_norm)
    return k, v.reshape(bsz, t_len, N_HEADS, HEAD_DIM)


def sb_attention(q, k, v):
    t_q = q.shape[1]
    off = k.shape[1] - t_q
    scale = HEAD_DIM ** -0.5
    outs = []
    for qs in range(0, t_q, Q_BLOCK):
        qe = min(qs + Q_BLOCK, t_q)
        kl = off + qe
        z = jnp.einsum('bqhd,bshd->bhqs', q[:, qs:qe], k[:, :kl], preferred_element_type=jnp.float32) * scale
        qpos = off + qs + jnp.arange(qe - qs)
        mask = jnp.arange(kl)[None, :] < qpos[:, None]
        log_beta = jax.nn.log_sigmoid(z)
        log_stay = jnp.where(mask, jax.nn.log_sigmoid(-z), 0.0)
        log_after = lax.cumsum(log_stay, axis=3, reverse=True) - log_stay
        w = jnp.where(mask, jnp.exp(log_beta + log_after), 0.0)
        outs.append(jnp.einsum('bhqs,bshd->bqhd', w.astype(v.dtype), v[:, :kl]))
    return jnp.concatenate(outs, axis=1)


def sb_mixer(x, k_all, v_all, norm, wq, q_norm, wo):
    bsz, t_len, _ = x.shape
    q = rmsnorm((rmsnorm(x, norm) @ wq).reshape(bsz, t_len, N_HEADS, HEAD_DIM), q_norm)
    o = sb_attention(q, k_all, v_all)
    return o.reshape(bsz, t_len, N_HEADS * HEAD_DIM) @ wo


def conv_ffn(x, prev, norm, w_up, conv_w, conv_b, w_down):
    g, u = jnp.split(rmsnorm(x, norm) @ w_up, 2, axis=-1)
    gc, new = causal_dwconv(g, prev, conv_w, conv_b)
    return (jax.nn.gelu(gc) * u) @ w_down, new


def trunk(x, lru_h, lru_conv, ffn_conv, cache_k, cache_v,
          a_norm, a_w_in, a_conv_w, a_conv_b, a_wr, a_br, a_wi, a_bi, a_lambda, a_w_out,
          kv_norm, w_kv, k_norm, b_norm, b_wq, q_norm, b_wo,
          f_norm, f_w_up, f_conv_w, f_conv_b, f_w_down, out_norm):
    h_out, c_out, f_out = [], [], []
    for l in range(DEPTH):
        if l < N_A_LAYERS:
            y, h_l, c_l = rglru_mixer(x, lru_h[l], lru_conv[l], a_norm[l], a_w_in[l], a_conv_w[l], a_conv_b[l],
                                      a_wr[l], a_br[l], a_wi[l], a_bi[l], a_lambda[l], a_w_out[l])
            h_out.append(h_l)
            c_out.append(c_l)
        else:
            if l == N_A_LAYERS:
                k_new, v_new = shared_kv(x, kv_norm, w_kv, k_norm)
                k_all = jnp.concatenate([cache_k.astype(x.dtype), k_new], axis=1)
                v_all = jnp.concatenate([cache_v.astype(x.dtype), v_new], axis=1)
            j = l - N_A_LAYERS
            y = sb_mixer(x, k_all, v_all, b_norm[j], b_wq[j], q_norm[j], b_wo[j])
        x = x + y
        y, f_l = conv_ffn(x, ffn_conv[l], f_norm[l], f_w_up[l], f_conv_w[l], f_conv_b[l], f_w_down[l])
        f_out.append(f_l)
        x = x + y
    return rmsnorm(x, out_norm), jnp.stack(h_out), jnp.stack(c_out), jnp.stack(f_out), k_new, v_new


def setup_inputs(seed: int = 0) -> dict:
    key = jax.random.key(seed)
    ks = jax.random.split(key, 40)
    f32 = jnp.float32
    def nrm(k, shape, s):
        return jax.random.normal(k, shape, f32) * s
    na, nb = N_A_LAYERS, N_B_LAYERS
    a0 = jax.random.uniform(ks[14], (na, LRU_WIDTH), f32, 0.9, 0.999)
    root = a0 ** (1.0 / LRU_C)
    a_lambda = jnp.log(root) - jnp.log1p(-root)
    return {
        'x_prompt': nrm(ks[0], (BATCH, SEQ, D_MODEL), 1.0),
        'x_sample': nrm(ks[1], (DEC_BATCH, DEC_SEQ, D_MODEL), 1.0),
        'state_lru_h': nrm(ks[2], (na, DEC_BATCH, LRU_WIDTH), 0.5),
        'state_lru_conv': nrm(ks[3], (na, DEC_BATCH, LRU_CONV - 1, LRU_WIDTH), 1.0),
        'state_ffn_conv': nrm(ks[4], (DEPTH, DEC_BATCH, FFN_CONV - 1, D_FF), 1.0),
        'cache_k': nrm(ks[5], (DEC_BATCH, PAST_LEN, N_HEADS, HEAD_DIM), 1.0),
        'cache_v': nrm(ks[6], (DEC_BATCH, PAST_LEN, N_HEADS, HEAD_DIM), 1.0),
        'a_norm': 1.0 + nrm(ks[7], (na, D_MODEL), 0.01),
        'a_w_in': nrm(ks[8], (na, D_MODEL, 2 * LRU_WIDTH), D_MODEL ** -0.5),
        'a_conv_w': nrm(ks[9], (na, LRU_CONV, LRU_WIDTH), LRU_CONV ** -0.5),
        'a_conv_b': nrm(ks[10], (na, LRU_WIDTH), 0.01),
        'a_wr': nrm(ks[11], (na, N_LRU_BLOCKS, LRU_BLOCK, LRU_BLOCK), LRU_BLOCK ** -0.5),
        'a_br': nrm(ks[12], (na, LRU_WIDTH), 0.01),
        'a_wi': nrm(ks[13], (na, N_LRU_BLOCKS, LRU_BLOCK, LRU_BLOCK), LRU_BLOCK ** -0.5),
        'a_bi': nrm(ks[15], (na, LRU_WIDTH), 0.01),
        'a_lambda': a_lambda,
        'a_w_out': nrm(ks[16], (na, LRU_WIDTH, D_MODEL), LRU_WIDTH ** -0.5),
        'kv_norm': 1.0 + nrm(ks[17], (D_MODEL,), 0.01),
        'w_kv': nrm(ks[18], (D_MODEL, 2 * N_HEADS * HEAD_DIM), D_MODEL ** -0.5),
        'k_norm': 1.0 + nrm(ks[19], (HEAD_DIM,), 0.01),
        'b_norm': 1.0 + nrm(ks[20], (nb, D_MODEL), 0.01),
        'b_wq': nrm(ks[21], (nb, D_MODEL, N_HEADS * HEAD_DIM), D_MODEL ** -0.5),
        'q_norm': 1.0 + nrm(ks[22], (nb, HEAD_DIM), 0.01),
        'b_wo': nrm(ks[23], (nb, N_HEADS * HEAD_DIM, D_MODEL), (N_HEADS * HEAD_DIM) ** -0.5),
        'f_norm': 1.0 + nrm(ks[24], (DEPTH, D_MODEL), 0.01),
        'f_w_up': nrm(ks[25], (DEPTH, D_MODEL, 2 * D_FF), D_MODEL ** -0.5),
        'f_conv_w': nrm(ks[26], (DEPTH, FFN_CONV, D_FF), FFN_CONV ** -0.5),
        'f_conv_b': nrm(ks[27], (DEPTH, D_FF), 0.01),
        'f_w_down': nrm(ks[28], (DEPTH, D_FF, D_MODEL), D_FF ** -0.5),
        'out_norm': 1.0 + nrm(ks[29], (D_MODEL,), 0.01),
    }


def reference(x_prompt, x_sample, state_lru_h, state_lru_conv, state_ffn_conv, cache_k, cache_v,
              a_norm, a_w_in, a_conv_w, a_conv_b, a_wr, a_br, a_wi, a_bi, a_lambda, a_w_out,
              kv_norm, w_kv, k_norm, b_norm, b_wq, q_norm, b_wo,
              f_norm, f_w_up, f_conv_w, f_conv_b, f_w_down, out_norm):
    assert x_sample.shape[1] <= CHUNK
    weights = (a_norm, a_w_in, a_conv_w, a_conv_b, a_wr, a_br, a_wi, a_bi, a_lambda, a_w_out,
               kv_norm, w_kv, k_norm, b_norm, b_wq, q_norm, b_wo,
               f_norm, f_w_up, f_conv_w, f_conv_b, f_w_down, out_norm)
    bp = x_prompt.shape[0]
    dt = x_prompt.dtype
    y_prompt, p_lru_h, p_lru_conv, p_ffn_conv, p_k, p_v = trunk(
        x_prompt,
        jnp.zeros((N_A_LAYERS, bp, LRU_WIDTH), dt),
        jnp.zeros((N_A_LAYERS, bp, LRU_CONV - 1, LRU_WIDTH), dt),
        jnp.zeros((DEPTH, bp, FFN_CONV - 1, D_FF), dt),
        jnp.zeros((bp, 0, N_HEADS, HEAD_DIM), dt),
        jnp.zeros((bp, 0, N_HEADS, HEAD_DIM), dt),
        *weights)
    y_sample, s_lru_h, s_lru_conv, s_ffn_conv, s_k, s_v = trunk(
        x_sample, state_lru_h, state_lru_conv, state_ffn_conv, cache_k, cache_v, *weights)
    return (y_prompt, y_sample, p_lru_h, p_lru_conv, p_ffn_conv, p_k, p_v,
            s_lru_h, s_lru_conv, s_ffn_conv, s_k, s_v)
```

```cpp
#include <hip/hip_runtime.h>
#include <hip/hip_cooperative_groups.h>
#include <cstdio>
#include <cstdint>
namespace cg = cooperative_groups;

#define DI __device__ __forceinline__
#define LAS __attribute__((address_space(3)))

constexpr int D = 1024, NB = 32, T = 2048, DB = 16, DT = 16, PAST = 4096, NH = 8, HD = 128, DFF = 3072, NBLK = 16, BLK = 64;
constexpr int MP = NB * T, MS = DB * DT, M = MP + MS;
constexpr float EPS = 1e-6f;
constexpr float LOG2E = 1.4426950408889634f;
constexpr float QSCALE = 0.08838834764831845f * LOG2E;

constexpr size_t O_YP = 0, O_YS = O_YP + (size_t)MP * D, O_PH = O_YS + (size_t)MS * D, O_PC = O_PH + (size_t)NB * D, O_PF = O_PC + (size_t)NB * 3 * D,
                 O_PK = O_PF + (size_t)2 * NB * 2 * DFF, O_PV = O_PK + (size_t)MP * D, O_SH = O_PV + (size_t)MP * D, O_SC = O_SH + (size_t)DB * D,
                 O_SF = O_SC + (size_t)DB * 3 * D, O_SK = O_SF + (size_t)2 * DB * 2 * DFF, O_SV = O_SK + (size_t)MS * D, O_END = O_SV + (size_t)MS * D;
static_assert(O_END == 202899456ull, "output size");

constexpr size_t MiB = 1u << 20;
constexpr size_t WS_WIN = 0, WS_WOUT = 4 * MiB, WS_WUP0 = 6 * MiB, WS_WUP1 = 18 * MiB, WS_WDN0 = 30 * MiB, WS_WDN1 = 36 * MiB, WS_WQKV = 42 * MiB, WS_WO = 48 * MiB,
                 WS_WRT = 50 * MiB, WS_WIT = 50 * MiB + 128 * 1024, WS_SS = 52 * MiB, WS_CW = 57 * MiB  , CW_BYTES = 16 * 1024, WS_XB = 58 * MiB, WS_BIG = 187 * MiB, WS_END = WS_BIG + (size_t)M * 6144 * 2;
static_assert(WS_XB + (size_t)M * D * 2 <= WS_BIG && WS_SS + (size_t)M * 16 * 4 <= WS_XB && WS_END <= 1024 * MiB, "ws map");

constexpr int LDS_BYTES = 147456;

typedef unsigned short bf16_t;
typedef float f32x2 __attribute__((ext_vector_type(2)));
typedef float f32x4 __attribute__((ext_vector_type(4)));
typedef float f32x16 __attribute__((ext_vector_type(16)));
typedef short bf16x8 __attribute__((ext_vector_type(8)));
typedef short s16x4 __attribute__((ext_vector_type(4)));
typedef unsigned u32x4 __attribute__((ext_vector_type(4)));
typedef unsigned u32x2 __attribute__((ext_vector_type(2)));
typedef __bf16 bf16x2_t __attribute__((ext_vector_type(2)));

DI unsigned pk2(float lo, float hi) { f32x2 v = {lo, hi}; bf16x2_t b = __builtin_convertvector(v, bf16x2_t); return __builtin_bit_cast(unsigned, b); }
DI float bflo(unsigned u) { return __uint_as_float(u << 16); }
DI float bfhi(unsigned u) { return __uint_as_float(u & 0xffff0000u); }
DI void unpack8(const u32x4 v, float (&f)[8]) { f[0] = bflo(v.x); f[1] = bfhi(v.x); f[2] = bflo(v.y); f[3] = bfhi(v.y); f[4] = bflo(v.z); f[5] = bfhi(v.z); f[6] = bflo(v.w); f[7] = bfhi(v.w); }
DI u32x4 pack8(const float (&f)[8]) { u32x4 w; w.x = pk2(f[0], f[1]); w.y = pk2(f[2], f[3]); w.z = pk2(f[4], f[5]); w.w = pk2(f[6], f[7]); return w; }
DI float fexp2(float x) { return __builtin_amdgcn_exp2f(x); }
DI float frcp(float x) { return __builtin_amdgcn_rcpf(x); }
DI float sigmoidf_(float x) { return frcp(1.0f + fexp2(-x * LOG2E)); }
DI float gelu_tanh(float x) { const float u = 0.7978845608028654f * (x + 0.044715f * x * x * x); return x * frcp(1.0f + fexp2(-2.0f * LOG2E * u)); }
DI float wave_sum(float v) {
#pragma unroll
    for (int o = 1; o < 64; o <<= 1) v += __shfl_xor(v, o);
    return v;
}
namespace pg8 {
#define PG8_LAS __attribute__((address_space(3)))
typedef unsigned short bf16_t;
typedef short bf16x8 __attribute__((ext_vector_type(8)));
typedef float f32x4 __attribute__((ext_vector_type(4)));
typedef unsigned u32x4 __attribute__((ext_vector_type(4)));
constexpr int BM = 256, BK = 64, HALF = 128, HTB = HALF * BK * 2  , STAGE_BYTES = 8 * HTB, NXCD = 8, WGM = 8;

__host__ __device__ __forceinline__ int lds_byte(int r, int c) { const int st = (r >> 4) * 2 + (c >> 5), rr = r & 15, cc = c & 31, ob = rr * 64 + cc * 2; return st * 1024 + (ob ^ (((ob >> 9) & 1) << 5)); }
__host__ __device__ __forceinline__ void stage_rc(int b, int& R, int& C) { const int st = b / 1024, sb = b % 1024, swz = sb ^ (((sb >> 9) & 1) << 5); R = (st >> 1) * 16 + swz / 64; C = (st & 1) * 32 + (swz % 64) / 2; }
__host__ __device__ __forceinline__ int perm32(int rho) { const int n = rho >> 4, i = rho & 15; return 8 * (i >> 2) + 4 * n + (i & 3); }

struct Unit { int pm, pn; };
struct Gemm { const bf16_t* A; const bf16_t* Bt; int M, N, K, lda; };

struct StaticOrder {
    int nM, nN, nwg, G, c;
    __host__ __device__ void init(int M, int N, int G_, int c_) { nM = M / BM; nN = N / BM; nwg = nM * nN; G = G_; c = c_; }
    __host__ __device__ bool next(int i, Unit& u) const {
        const long L = (long)i * G + c; if (L >= nwg) return false;
        int wgid = (int)L; { const int q = nwg / NXCD, r = nwg % NXCD, xcd = wgid % NXCD, off = wgid / NXCD; wgid = (xcd < r ? xcd * (q + 1) : r * (q + 1) + (xcd - r) * q) + off; }
        const int nig = WGM * nN, gid = wgid / nig, fm = gid * WGM, gsz = (nM - fm) < WGM ? (nM - fm) : WGM;
        u.pm = fm + ((wgid % nig) % gsz); u.pn = (wgid % nig) / gsz; return true;
    }
    __device__ __forceinline__ void a_ready(const Unit&) const {}
    __device__ __forceinline__ void done(const Unit&) const {}
};
__device__ __forceinline__ unsigned cvt_pk_bf16(float lo, float hi) { unsigned r; asm volatile("v_cvt_pk_bf16_f32 %0, %1, %2" : "=v"(r) : "v"(lo), "v"(hi)); return r; }
DI float row_rstd(const float* ss, int row) {
    const f32x4* p = (const f32x4*)(ss + (size_t)row * 16);
    const f32x4 a = p[0], b = p[1], c = p[2], d = p[3];
    const float s = ((a[0] + a[1]) + (a[2] + a[3])) + ((b[0] + b[1]) + (b[2] + b[3])) + ((c[0] + c[1]) + (c[2] + c[3])) + ((d[0] + d[1]) + (d[2] + d[3]));
    return __builtin_amdgcn_rsqf(s * (1.0f / 1024.0f) + 1e-6f);
}
struct EpiScaleBf16 {
    static constexpr bool PERM = true, AFTER_DRAIN = false;
    bf16_t* O; int ldc; const float* ss;
    DI void operator()(const f32x4 (&acc)[2][2][4][2], const Unit& u, int wr, int wc, int fr, int fq) const {
        const int row0 = u.pm * BM + wr * 64 + fr, col0 = u.pn * BM + wc * 32 + 8 * fq;
#pragma unroll
        for (int ai = 0; ai < 2; ++ai)
#pragma unroll
            for (int m = 0; m < 4; ++m) {
                const int row = row0 + ai * HALF + m * 16;
                const float sc = ss ? row_rstd(ss, row) : 1.0f;
                bf16_t* rowp = O + (size_t)row * ldc + col0;
#pragma unroll
                for (int bj = 0; bj < 2; ++bj) {
                    const f32x4 v0 = acc[ai][bj][m][0] * sc, v1 = acc[ai][bj][m][1] * sc;
                    u32x4 w; w.x = cvt_pk_bf16(v0[0], v0[1]); w.y = cvt_pk_bf16(v0[2], v0[3]); w.z = cvt_pk_bf16(v1[0], v1[1]); w.w = cvt_pk_bf16(v1[2], v1[3]);
                    *(u32x4*)(rowp + bj * HALF) = w;
                }
                if (m & 1) asm volatile("" ::: "memory");
            }
    }
};
struct EpiResid {
    static constexpr bool PERM = true, AFTER_DRAIN = false;
    bf16_t* XB; float* ss;
    DI void operator()(const f32x4 (&acc)[2][2][4][2], const Unit& u, int wr, int wc, int fr, int fq) const {
        const int row0 = u.pm * BM + wr * 64 + fr, col0 = u.pn * BM + wc * 32 + 8 * fq;
#pragma unroll
        for (int ai = 0; ai < 2; ++ai)
#pragma unroll
            for (int m = 0; m < 4; ++m) {
                const int row = row0 + ai * HALF + m * 16;
                bf16_t* xb = XB + (size_t)row * 1024 + col0;
                float sq = 0.f;
#pragma unroll
                for (int bj = 0; bj < 2; ++bj) {
                    const u32x4 r = *(const u32x4*)(xb + bj * HALF);
                    const f32x4 r0 = {__uint_as_float(r.x << 16), __uint_as_float(r.x & 0xffff0000u), __uint_as_float(r.y << 16), __uint_as_float(r.y & 0xffff0000u)};
                    const f32x4 r1 = {__uint_as_float(r.z << 16), __uint_as_float(r.z & 0xffff0000u), __uint_as_float(r.w << 16), __uint_as_float(r.w & 0xffff0000u)};
                    const f32x4 v0 = acc[ai][bj][m][0] + r0, v1 = acc[ai][bj][m][1] + r1;
                    u32x4 w; w.x = cvt_pk_bf16(v0[0], v0[1]); w.y = cvt_pk_bf16(v0[2], v0[3]); w.z = cvt_pk_bf16(v1[0], v1[1]); w.w = cvt_pk_bf16(v1[2], v1[3]);
                    *(u32x4*)(xb + bj * HALF) = w;
                    sq += (v0[0] * v0[0] + v0[1] * v0[1]) + (v0[2] * v0[2] + v0[3] * v0[3]) + (v1[0] * v1[0] + v1[1] * v1[1]) + (v1[2] * v1[2] + v1[3] * v1[3]);
                }
                sq += __shfl_xor(sq, 16); sq += __shfl_xor(sq, 32);
                if (fq == 0) ss[(size_t)row * 16 + u.pn * 4 + wc] = sq;
                if (m & 1) asm volatile("" ::: "memory");
            }
    }
};
struct EpiFfn {
    static constexpr bool PERM = true, AFTER_DRAIN = false;
    bf16_t* H; bf16_t* EG; bf16_t* EU; const float* ss; const float* cw; const float* cb;
    DI void operator()(const f32x4 (&acc)[2][2][4][2], const Unit& u, int wr, int wc, int fr, int fq) const {
        const int row0 = u.pm * BM + wr * 64 + fr, hc = u.pn * HALF + wc * 32 + 8 * fq;
        float w0[8], w1[8], w2[8], bb[8];
        { const f32x4 a0 = *(const f32x4*)(cw + hc), a1 = *(const f32x4*)(cw + hc + 4), b0 = *(const f32x4*)(cw + 3072 + hc), b1 = *(const f32x4*)(cw + 3072 + hc + 4),
                      c0 = *(const f32x4*)(cw + 6144 + hc), c1 = *(const f32x4*)(cw + 6144 + hc + 4), d0 = *(const f32x4*)(cb + hc), d1 = *(const f32x4*)(cb + hc + 4);
#pragma unroll
          for (int i = 0; i < 4; ++i) { w0[i] = a0[i]; w0[i + 4] = a1[i]; w1[i] = b0[i]; w1[i + 4] = b1[i]; w2[i] = c0[i]; w2[i + 4] = c1[i]; bb[i] = d0[i]; bb[i + 4] = d1[i]; } }
#pragma unroll
        for (int ai = 0; ai < 2; ++ai)
#pragma unroll
            for (int m = 0; m < 4; ++m) {
                const int row = row0 + ai * HALF + m * 16;
                const float sc = row_rstd(ss, row);
                float g[8], uu[8];
#pragma unroll
                for (int i = 0; i < 4; ++i) { g[i] = acc[ai][0][m][0][i] * sc; g[i + 4] = acc[ai][0][m][1][i] * sc; uu[i] = acc[ai][1][m][0][i] * sc; uu[i + 4] = acc[ai][1][m][1][i] * sc; }
                u32x4 hw; unsigned hp[4];
#pragma unroll
                for (int i = 0; i < 8; i += 2) {
                    const float pa1 = __shfl_up(g[i], 1, 16), pa2 = __shfl_up(g[i], 2, 16), pb1 = __shfl_up(g[i + 1], 1, 16), pb2 = __shfl_up(g[i + 1], 2, 16);
                    const float ca = bb[i] + w0[i] * pa2 + w1[i] * pa1 + w2[i] * g[i], cb2 = bb[i + 1] + w0[i + 1] * pb2 + w1[i + 1] * pb1 + w2[i + 1] * g[i + 1];
                    const float ua = 0.7978845608028654f * (ca + 0.044715f * ca * ca * ca), ub = 0.7978845608028654f * (cb2 + 0.044715f * cb2 * cb2 * cb2);
                    const float ha = ca * __builtin_amdgcn_rcpf(1.0f + __builtin_amdgcn_exp2f(-2.8853900817779268f * ua)) * uu[i];
                    const float hb = cb2 * __builtin_amdgcn_rcpf(1.0f + __builtin_amdgcn_exp2f(-2.8853900817779268f * ub)) * uu[i + 1];
                    hp[i >> 1] = cvt_pk_bf16(ha, hb);
                }
                hw.x = hp[0]; hw.y = hp[1]; hw.z = hp[2]; hw.w = hp[3];
                if (fr >= 2) *(u32x4*)(H + (size_t)row * 3072 + hc) = hw;
                if (fr >= 14 || fr < 2) {
                    u32x4 gw; gw.x = cvt_pk_bf16(g[0], g[1]); gw.y = cvt_pk_bf16(g[2], g[3]); gw.z = cvt_pk_bf16(g[4], g[5]); gw.w = cvt_pk_bf16(g[6], g[7]);
                    *(u32x4*)(EG + ((size_t)(row >> 4) * 4 + ((fr + 2) & 3)) * 3072 + hc) = gw;
                    if (fr < 2) { u32x4 uw; uw.x = cvt_pk_bf16(uu[0], uu[1]); uw.y = cvt_pk_bf16(uu[2], uu[3]); uw.z = cvt_pk_bf16(uu[4], uu[5]); uw.w = cvt_pk_bf16(uu[6], uu[7]);
                        *(u32x4*)(EU + ((size_t)(row >> 4) * 2 + fr) * 3072 + hc) = uw; }
                }
                asm volatile("" ::: "memory");
            }
    }
};

struct EpiQkv {
    static constexpr bool PERM = true, AFTER_DRAIN = false;
    bf16_t* O; float* outp; const float* ss; const float* kn; const float* qn; PG8_LAS float* part;
    size_t o_pk, o_pv, o_sk, o_sv; int mp; float qscale;
    DI void operator()(const f32x4 (&acc)[2][2][4][2], const Unit& u, int wr, int wc, int fr, int fq) const {
        const int kind = u.pn >> 2;
        const int row0 = u.pm * BM + wr * 64 + fr, col0 = u.pn * BM + wc * 32 + 8 * fq, hcol = (u.pn & 3) * BM + wc * 32 + 8 * fq;
        if (kind == 1) {
#pragma unroll
            for (int ai = 0; ai < 2; ++ai)
#pragma unroll
                for (int m = 0; m < 4; ++m) {
                    const int row = row0 + ai * HALF + m * 16;
                    const float sc = row_rstd(ss, row);
                    const size_t ob = (row < mp ? o_pv + (size_t)row * 1024 : o_sv + (size_t)(row - mp) * 1024) + hcol;
#pragma unroll
                    for (int bj = 0; bj < 2; ++bj) {
                        const f32x4 v0 = acc[ai][bj][m][0] * sc, v1 = acc[ai][bj][m][1] * sc;
                        *(f32x4*)(outp + ob + bj * HALF) = v0; *(f32x4*)(outp + ob + bj * HALF + 4) = v1;
                        u32x4 w; w.x = cvt_pk_bf16(v0[0], v0[1]); w.y = cvt_pk_bf16(v0[2], v0[3]); w.z = cvt_pk_bf16(v1[0], v1[1]); w.w = cvt_pk_bf16(v1[2], v1[3]);
                        *(u32x4*)(O + (size_t)row * 3072 + col0 + bj * HALF) = w;
                    }
                    if (m & 1) asm volatile("" ::: "memory");
                }
            return;
        }
        float scr[2][4];
#pragma unroll
        for (int ai = 0; ai < 2; ++ai)
#pragma unroll
            for (int m = 0; m < 4; ++m) {
                const int rl = ai * HALF + wr * 64 + m * 16 + fr;
                const float sc = row_rstd(ss, u.pm * BM + rl); scr[ai][m] = sc;
#pragma unroll
                for (int bj = 0; bj < 2; ++bj) {
                    const f32x4 v0 = acc[ai][bj][m][0] * sc, v1 = acc[ai][bj][m][1] * sc;
                    float s = (v0[0] * v0[0] + v0[1] * v0[1]) + (v0[2] * v0[2] + v0[3] * v0[3]) + (v1[0] * v1[0] + v1[1] * v1[1]) + (v1[2] * v1[2] + v1[3] * v1[3]);
                    s += __shfl_xor(s, 16); s += __shfl_xor(s, 32);
                    if (fq == 0) part[(rl * 2 + bj) * 4 + wc] = s;
                }
            }
        asm volatile("s_waitcnt lgkmcnt(0)" ::: "memory"); __builtin_amdgcn_s_barrier(); asm volatile("" ::: "memory");
        const float* gp = (kind == 0 ? kn : qn) + wc * 32 + 8 * fq;
        const float gm = kind == 0 ? 1.0f : qscale;
        const f32x4 g0 = *(const f32x4*)gp * gm, g1 = *(const f32x4*)(gp + 4) * gm;
#pragma unroll
        for (int ai = 0; ai < 2; ++ai)
#pragma unroll
            for (int m = 0; m < 4; ++m) {
                const int rl = ai * HALF + wr * 64 + m * 16 + fr, row = u.pm * BM + rl;
                const size_t ob = (row < mp ? o_pk + (size_t)row * 1024 : o_sk + (size_t)(row - mp) * 1024) + hcol;
#pragma unroll
                for (int bj = 0; bj < 2; ++bj) {
                    const f32x4 ps = *(const PG8_LAS f32x4*)(part + (rl * 2 + bj) * 4);
                    const float rs = __builtin_amdgcn_rsqf(((ps[0] + ps[1]) + (ps[2] + ps[3])) * (1.0f / 128.0f) + 1e-6f) * scr[ai][m];
                    const f32x4 v0 = acc[ai][bj][m][0] * rs * g0, v1 = acc[ai][bj][m][1] * rs * g1;
                    if (kind == 0) { *(f32x4*)(outp + ob + bj * HALF) = v0; *(f32x4*)(outp + ob + bj * HALF + 4) = v1; }
                    u32x4 w; w.x = cvt_pk_bf16(v0[0], v0[1]); w.y = cvt_pk_bf16(v0[2], v0[3]); w.z = cvt_pk_bf16(v1[0], v1[1]); w.w = cvt_pk_bf16(v1[2], v1[3]);
                    *(u32x4*)(O + (size_t)row * 3072 + col0 + bj * HALF) = w;
                }
                if (m & 1) asm volatile("" ::: "memory");
            }
    }
};
template <class Epi, class Sched, bool ALIGN_EPI = false, bool SP2 = false>
__device__ __forceinline__ void gemm_phase(PG8_LAS unsigned char* lds, const Gemm g, const Sched& S, const Epi& E) {
    int tid = threadIdx.x; asm volatile("" : "+v"(tid)); const int wid = __builtin_amdgcn_readfirstlane(tid >> 6), lane = tid & 63, wr = wid >> 2, wc = wid & 3, fr = lane & 15, fq = lane >> 4;
    const int K = g.K, nt = K / BK;
    unsigned voffA[2], voffB[2];
#pragma unroll
    for (int i = 0; i < 2; ++i) { int R, C; stage_rc(tid * 16 + i * 8192, R, C); const int Rb = Epi::PERM ? ((R & ~31) + perm32(R & 31)) : R;
        voffA[i] = (unsigned)(R * g.lda + C) * 2u; voffB[i] = (unsigned)(Rb * K + C) * 2u; }
    const size_t kstep = (size_t)(BK * 2);
    const size_t hstep = (size_t)HALF * K * 2;
    const size_t tstep = 2 * hstep; const size_t hstepA = (size_t)HALF * g.lda * 2, tstepA = 2 * hstepA;
    const unsigned ldsw = (unsigned)wid * 1024u;
    const int aoff = lds_byte(wr * 64 + fr, fq * 8), boff = lds_byte(wc * 32 + fr, fq * 8);
#define PG8_SA(b, h) (((b) * 2 + (h)) * HTB)
#define PG8_SB(b, h) ((4 + (b) * 2 + (h)) * HTB)
#define PG8_STAGE(bufoff, gbase, voff) do { _Pragma("unroll") for (int _i = 0; _i < 2; ++_i) \
        __builtin_amdgcn_global_load_lds((const unsigned*)((const char*)(gbase) + (voff)[_i]), (PG8_LAS unsigned*)(lds + (bufoff) + ldsw + _i * 8192), 16, 0, 0); } while (0)
#define PG8_LDA(dst, b, h) do { _Pragma("unroll") for (int m = 0; m < 4; ++m) _Pragma("unroll") for (int k = 0; k < 2; ++k) dst[m][k] = *(const PG8_LAS bf16x8*)(lds + PG8_SA(b, h) + aoff + m * 2048 + k * 1024); } while (0)
#define PG8_LDB(dst, b, h) do { _Pragma("unroll") for (int n = 0; n < 2; ++n) _Pragma("unroll") for (int k = 0; k < 2; ++k) dst[n][k] = *(const PG8_LAS bf16x8*)(lds + PG8_SB(b, h) + boff + n * 2048 + k * 1024); } while (0)
#define PG8_MMA(ai, bj, At, Bt) do { __builtin_amdgcn_s_setprio(1); _Pragma("unroll") for (int m = 0; m < 4; ++m) _Pragma("unroll") for (int n = 0; n < 2; ++n) _Pragma("unroll") for (int k = 0; k < 2; ++k) \
        acc[ai][bj][m][n] = __builtin_amdgcn_mfma_f32_16x16x32_bf16(Bt[n][k], At[m][k], acc[ai][bj][m][n], 0, 0, 0); __builtin_amdgcn_s_setprio(0); } while (0)
#define PG8_WAIT_V(n) asm volatile("s_waitcnt vmcnt(" #n ")" ::: "memory")
#define PG8_WAIT_L(n) asm volatile("s_waitcnt lgkmcnt(" #n ")" ::: "memory")
#define PG8_BAR __builtin_amdgcn_s_barrier()
#define PG8_SCHED __builtin_amdgcn_sched_barrier(0)
    Unit cur, nxt; int ui = 0;
    if (!S.next(0, cur)) return;
    f32x4 acc[2][2][4][2];
#pragma unroll
    for (int a = 0; a < 2; ++a)
#pragma unroll
        for (int b = 0; b < 2; ++b)
#pragma unroll
            for (int m = 0; m < 4; ++m)
#pragma unroll
                for (int n = 0; n < 2; ++n) acc[a][b][m][n] = (f32x4){0.f, 0.f, 0.f, 0.f};
    bf16x8 At[4][2], B0[2][2], B1[2][2];
    const char* cA = (const char*)g.A + (size_t)cur.pm * tstepA; const char* cB = (const char*)g.Bt + (size_t)cur.pn * tstep;
    S.a_ready(cur);
    if constexpr (SP2) {
        PG8_STAGE(PG8_SB(0, 0), cB, voffB); PG8_STAGE(PG8_SB(0, 1), cB + hstep, voffB); PG8_STAGE(PG8_SA(0, 0), cA, voffA); PG8_STAGE(PG8_SA(0, 1), cA + hstepA, voffA);
        if (wr == 1) PG8_BAR;
        PG8_WAIT_V(2); PG8_BAR;
        PG8_STAGE(PG8_SB(1, 0), cB + kstep, voffB); PG8_STAGE(PG8_SA(1, 0), cA + kstep, voffA); PG8_STAGE(PG8_SB(1, 1), cB + hstep + kstep, voffB);
        PG8_WAIT_V(6); PG8_BAR;
    } else {
        PG8_STAGE(PG8_SB(0, 0), cB, voffB); PG8_STAGE(PG8_SA(0, 0), cA, voffA); PG8_STAGE(PG8_SB(0, 1), cB + hstep, voffB); PG8_STAGE(PG8_SA(0, 1), cA + hstepA, voffA);
        if (wr == 1) PG8_BAR;
        PG8_WAIT_V(4); PG8_BAR;
        PG8_STAGE(PG8_SB(1, 0), cB + kstep, voffB); PG8_STAGE(PG8_SA(1, 0), cA + kstep, voffA); PG8_STAGE(PG8_SB(1, 1), cB + hstep + kstep, voffB);
        PG8_WAIT_V(6); PG8_BAR;
    }
    for (;;) {
        const bool has_next = S.next(ui + 1, nxt);
        const char* nA = has_next ? (const char*)g.A + (size_t)nxt.pm * tstepA : cA; const char* nB = has_next ? (const char*)g.Bt + (size_t)nxt.pn * tstep : cB;
        for (int t = 0; t < nt; t += 2) {
            const bool last = (t == nt - 2);
            const char* a1 = cA + (size_t)(t + 1) * kstep;
            const char* a2 = last ? nA : cA + (size_t)(t + 2) * kstep; const char* b2 = last ? nB : cB + (size_t)(t + 2) * kstep;
            const char* a3 = a2 + kstep; const char* b3 = b2 + kstep;
            if (last && has_next) S.a_ready(nxt);
            if constexpr (SP2) {
            PG8_LDB(B0, 0, 0); PG8_LDB(B1, 0, 1); PG8_SCHED; PG8_LDA(At, 0, 0); PG8_STAGE(PG8_SA(1, 1), a1 + hstepA, voffA);
            PG8_WAIT_V(8); PG8_WAIT_L(0); PG8_BAR; PG8_MMA(0, 0, At, B0); PG8_MMA(0, 1, At, B1); PG8_BAR; PG8_SCHED;
            PG8_LDA(At, 0, 1); PG8_STAGE(PG8_SB(0, 0), b2, voffB); PG8_STAGE(PG8_SB(0, 1), b2 + hstep, voffB); PG8_STAGE(PG8_SA(0, 0), a2, voffA);
            PG8_WAIT_V(8); PG8_WAIT_L(0); PG8_BAR; PG8_MMA(1, 0, At, B0); PG8_MMA(1, 1, At, B1); PG8_BAR; PG8_SCHED;
            PG8_LDB(B0, 1, 0); PG8_LDB(B1, 1, 1); PG8_SCHED; PG8_LDA(At, 1, 0); PG8_STAGE(PG8_SA(0, 1), a2 + hstepA, voffA);
            PG8_WAIT_V(8); PG8_WAIT_L(0); PG8_BAR; PG8_MMA(0, 0, At, B0); PG8_MMA(0, 1, At, B1); PG8_BAR; PG8_SCHED;
            PG8_LDA(At, 1, 1); PG8_STAGE(PG8_SB(1, 0), b3, voffB); PG8_STAGE(PG8_SB(1, 1), b3 + hstep, voffB); PG8_STAGE(PG8_SA(1, 0), a3, voffA);
            PG8_WAIT_V(8); PG8_WAIT_L(0); PG8_BAR; PG8_MMA(1, 0, At, B0); PG8_MMA(1, 1, At, B1); PG8_BAR; PG8_SCHED;
            } else {
            PG8_LDB(B0, 0, 0); PG8_SCHED; PG8_LDA(At, 0, 0); PG8_STAGE(PG8_SA(1, 1), a1 + hstepA, voffA);
            PG8_WAIT_L(8); PG8_BAR; PG8_WAIT_L(0); PG8_MMA(0, 0, At, B0); PG8_BAR; PG8_SCHED;
            PG8_LDB(B1, 0, 1); PG8_STAGE(PG8_SB(0, 0), b2, voffB);
            PG8_BAR; PG8_WAIT_L(0); PG8_MMA(0, 1, At, B1); PG8_BAR;
            PG8_LDA(At, 0, 1); PG8_STAGE(PG8_SA(0, 0), a2, voffA);
            PG8_BAR; PG8_WAIT_L(0); PG8_MMA(1, 0, At, B0); PG8_BAR; PG8_SCHED;
            PG8_STAGE(PG8_SB(0, 1), b2 + hstep, voffB);
            PG8_WAIT_V(6); PG8_BAR; PG8_MMA(1, 1, At, B1); PG8_BAR;
            PG8_LDB(B0, 1, 0); PG8_SCHED; PG8_LDA(At, 1, 0); PG8_STAGE(PG8_SA(0, 1), a2 + hstepA, voffA);
            PG8_WAIT_L(8); PG8_BAR; PG8_WAIT_L(0); PG8_MMA(0, 0, At, B0); PG8_BAR; PG8_SCHED;
            PG8_LDB(B1, 1, 1); PG8_STAGE(PG8_SB(1, 0), b3, voffB);
            PG8_BAR; PG8_WAIT_L(0); PG8_MMA(0, 1, At, B1); PG8_BAR;
            PG8_LDA(At, 1, 1); PG8_STAGE(PG8_SA(1, 0), a3, voffA);
            PG8_BAR; PG8_WAIT_L(0); PG8_MMA(1, 0, At, B0); PG8_BAR; PG8_SCHED;
            PG8_STAGE(PG8_SB(1, 1), b3 + hstep, voffB);
            PG8_WAIT_V(6); PG8_BAR; PG8_MMA(1, 1, At, B1); PG8_BAR;
            }
        }
        if constexpr (ALIGN_EPI) { if (wr == 0) PG8_BAR; }
        if constexpr (!Epi::AFTER_DRAIN) { E(acc, cur, wr, wc, fr, fq); S.done(cur); }
        if (!has_next) break;
#pragma unroll
        for (int a = 0; a < 2; ++a)
#pragma unroll
            for (int b = 0; b < 2; ++b)
#pragma unroll
                for (int m = 0; m < 4; ++m)
#pragma unroll
                    for (int n = 0; n < 2; ++n) acc[a][b][m][n] = (f32x4){0.f, 0.f, 0.f, 0.f};
        cur = nxt; cA = nA; cB = nB; ++ui;
        if constexpr (ALIGN_EPI) { if (wr == 1) PG8_BAR; }
    }
    PG8_WAIT_V(0);
    if constexpr (!ALIGN_EPI) { if (wr == 0) PG8_BAR; }
    PG8_BAR;
    if constexpr (Epi::AFTER_DRAIN) { E.fused(acc, cur, wr, wc, fr, fq, lds, wid, lane); S.done(cur); }
#undef PG8_SA
#undef PG8_SB
#undef PG8_STAGE
#undef PG8_LDA
#undef PG8_LDB
#undef PG8_MMA
#undef PG8_WAIT_V
#undef PG8_WAIT_L
#undef PG8_BAR
#undef PG8_SCHED
}
}

struct Params { const float* in[30]; float* out; unsigned char* ws; };
typedef const __attribute__((address_space(4))) Params* PP;

DI int otid() { int t = threadIdx.x; asm volatile("" : "+v"(t)); return t; }
DI int obid() { int t = blockIdx.x; asm volatile("" : "+s"(t)); return t; }
DI int ogrid() { int t = gridDim.x; asm volatile("" : "+s"(t)); return t; }
#define LDS_WAIT() asm volatile("s_waitcnt lgkmcnt(0)" ::: "memory")
#define MFMA16(a, b, c) __builtin_amdgcn_mfma_f32_16x16x32_bf16((a), (b), (c), 0, 0, 0)
#define MFMA32(a, b, c) __builtin_amdgcn_mfma_f32_32x32x16_bf16((a), (b), (c), 0, 0, 0)

template <bool FFN_PERM = false>
DI void p0_transpose_item(const float* W, const float* gk, int K, int N, bf16_t* WT, int row_off, LAS float* scr, int item, int lane) {
    const int nblk = N / 32, kb = item / nblk, nb = item % nblk, k0 = 64 * kb, n0 = 32 * nb;
    if (FFN_PERM) { const int j = n0 < 3072 ? n0 : n0 - 3072; row_off = (j >> 7) * 256 + (n0 < 3072 ? 0 : 128) + (j & 127) - n0; }
#pragma unroll 8
    for (int i = 0; i < 32; ++i) { const int kk = 2 * i + (lane >> 5); const float gv = gk ? gk[k0 + kk] : 1.0f; scr[kk * 33 + (lane & 31)] = W[(size_t)(k0 + kk) * N + n0 + (lane & 31)] * gv; }
    LDS_WAIT(); asm volatile("" ::: "memory");
    const int c = lane & 7;
#pragma unroll
    for (int j = 0; j < 4; ++j) { const int n = (lane >> 3) + 8 * j; const LAS float* s = scr + (8 * c) * 33 + n;
        u32x4 o; o.x = pk2(s[0 * 33], s[1 * 33]); o.y = pk2(s[2 * 33], s[3 * 33]); o.z = pk2(s[4 * 33], s[5 * 33]); o.w = pk2(s[6 * 33], s[7 * 33]);
        *(u32x4*)(WT + (size_t)(row_off + n0 + n) * K + k0 + 8 * c) = o; }
    LDS_WAIT(); asm volatile("" ::: "memory");
}
DI void phase0(PP pp, LAS unsigned char* lds, int lane, int wave) {
    LAS float* scr = (LAS float*)(lds + wave * 16384);
    const int gw = obid() * 8 + wave, NGW = ogrid() * 8;
    unsigned char* ws = pp->ws;
    for (int it = gw; it < 12864; it += NGW) {
        int r = it;
        if (r < 1024) { p0_transpose_item(pp->in[8], pp->in[7], 1024, 2048, (bf16_t*)(ws + WS_WIN), 0, scr, r, lane); continue; } r -= 1024;
        if (r < 512) { p0_transpose_item(pp->in[16], nullptr, 1024, 1024, (bf16_t*)(ws + WS_WOUT), 0, scr, r, lane); continue; } r -= 512;
        if (r < 3072) { p0_transpose_item<true>(pp->in[25], pp->in[24], 1024, 6144, (bf16_t*)(ws + WS_WUP0), 0, scr, r, lane); continue; } r -= 3072;
        if (r < 3072) { p0_transpose_item<true>(pp->in[25] + (size_t)1024 * 6144, pp->in[24] + 1024, 1024, 6144, (bf16_t*)(ws + WS_WUP1), 0, scr, r, lane); continue; } r -= 3072;
        if (r < 1536) { p0_transpose_item(pp->in[28], nullptr, 3072, 1024, (bf16_t*)(ws + WS_WDN0), 0, scr, r, lane); continue; } r -= 1536;
        if (r < 1536) { p0_transpose_item(pp->in[28] + (size_t)3072 * 1024, nullptr, 3072, 1024, (bf16_t*)(ws + WS_WDN1), 0, scr, r, lane); continue; } r -= 1536;
        if (r < 1024) { p0_transpose_item(pp->in[18], pp->in[17], 1024, 2048, (bf16_t*)(ws + WS_WQKV), 0, scr, r, lane); continue; } r -= 1024;
        if (r < 512) { p0_transpose_item(pp->in[21], pp->in[20], 1024, 1024, (bf16_t*)(ws + WS_WQKV), 2048, scr, r, lane); continue; } r -= 512;
        if (r < 512) { p0_transpose_item(pp->in[23], nullptr, 1024, 1024, (bf16_t*)(ws + WS_WO), 0, scr, r, lane); continue; } r -= 512;
        if (r < 32) { const int blk = r >> 1; p0_transpose_item(pp->in[11] + blk * 4096, nullptr, 64, 64, (bf16_t*)(ws + WS_WRT) + blk * 4096, 0, scr, r & 1, lane); continue; } r -= 32;
        { const int blk = r >> 1; p0_transpose_item(pp->in[13] + blk * 4096, nullptr, 64, 64, (bf16_t*)(ws + WS_WIT) + blk * 4096, 0, scr, r & 1, lane); }
    }
    bf16_t* XB = (bf16_t*)(ws + WS_XB);
    float* SSp = (float*)(ws + WS_SS);
    for (int m4 = gw * 4; m4 < M; m4 += NGW * 4) {
        const float* xbase = m4 < MP ? pp->in[0] + (size_t)m4 * D : pp->in[1] + (size_t)(m4 - MP) * D;
        f32x4 v[4][4];
#pragma unroll
        for (int r = 0; r < 4; ++r)
#pragma unroll
            for (int j = 0; j < 4; ++j) v[r][j] = *((const f32x4*)(xbase + (size_t)r * D) + lane + 64 * j);
#pragma unroll
        for (int r = 0; r < 4; ++r) {
            float s = 0.f;
            u32x2* o8 = (u32x2*)(XB + (size_t)(m4 + r) * D) + lane;
#pragma unroll
            for (int j = 0; j < 4; ++j) { s += (v[r][j][0] * v[r][j][0] + v[r][j][1] * v[r][j][1]) + (v[r][j][2] * v[r][j][2] + v[r][j][3] * v[r][j][3]);
                u32x2 w; w.x = pk2(v[r][j][0], v[r][j][1]); w.y = pk2(v[r][j][2], v[r][j][3]); o8[64 * j] = w; }
            s = wave_sum(s);
            if (lane < 4) *((f32x4*)(SSp + (size_t)(m4 + r) * 16) + lane) = (f32x4){lane == 0 ? s : 0.f, 0.f, 0.f, 0.f};
        }
    }
}

DI void lru_phase(PP pp, LAS unsigned char* lds, int tid, int lane, int wave) {
    const bf16_t* GR = (const bf16_t*)(pp->ws + WS_BIG);
    bf16_t* HG = (bf16_t*)(pp->ws + WS_BIG + (size_t)M * 2048 * 2);
    const bf16_t* WRT = (const bf16_t*)(pp->ws + WS_WRT); const bf16_t* WIT = (const bf16_t*)(pp->ws + WS_WIT);
    LAS unsigned char* sWr = lds; LAS unsigned char* sWi = lds + 9216; LAS unsigned char* sCb = lds + 18432;
    LAS float* sA = (LAS float*)(lds + 36864); LAS float* sB = (LAS float*)(lds + 69632);
    LAS float* segA = (LAS float*)(lds + 102400); LAS float* segB = (LAS float*)(lds + 104448);
    LAS float* carry = (LAS float*)(lds + 106496); LAS float* par = (LAS float*)(lds + 106752);
#if defined(PROBE_L2B)
    for (int unit_ = obid(); unit_ < 1536; unit_ += ogrid()) { const int unit = unit_ >= 768 ? unit_ - 768 : unit_;
#else
    for (int unit = obid(); unit < 768; unit += ogrid()) {
#endif
        const bool smp = unit >= 512; const int su = smp ? unit - 512 : unit; const int b = su >> 4, n = su & 15;
        const int m0 = smp ? MP + b * DT : b * T; const int TT = smp ? DT : T;
        float* out_h = pp->out + (smp ? O_SH : O_PH) + (size_t)b * D + n * 64;
        float* out_c = pp->out + (smp ? O_SC : O_PC) + (size_t)b * 3 * D + n * 64;
        const float* st_conv = pp->in[3] + (size_t)b * 3 * D + n * 64;
        if (tid < 64) {
            const int ch = n * 64 + tid;
#pragma unroll
            for (int k = 0; k < 4; ++k) par[k * 64 + tid] = pp->in[9][k * 1024 + ch];
            par[4 * 64 + tid] = pp->in[10][ch]; par[5 * 64 + tid] = pp->in[12][ch]; par[6 * 64 + tid] = pp->in[14][ch];
            const float lam = pp->in[15][ch];
            par[7 * 64 + tid] = 8.0f * (fminf(lam, 0.f) - log1pf(expf(-fabsf(lam))));
            carry[tid] = smp ? pp->in[2][(size_t)b * D + ch] : 0.f;
        }
        { const int row = tid >> 3, ck = tid & 7;
          *(LAS u32x4*)(sWr + row * 144 + ck * 16) = *(const u32x4*)(WRT + n * 4096 + row * 64 + ck * 8);
          *(LAS u32x4*)(sWi + row * 144 + ck * 16) = *(const u32x4*)(WIT + n * 4096 + row * 64 + ck * 8); }
        __syncthreads();
        const int nch = (TT + 127) >> 7;
        u32x4 xr[2][4], gtv[2];
#define LRU_LOAD_REC(t0_) do { _Pragma("unroll") for (int i = 0; i < 2; ++i) { const int item = tid + 512 * i, tl = item >> 3, gq = item & 7, t = (t0_) + tl; \
            _Pragma("unroll") for (int k = 0; k < 4; ++k) { const int tt = t - 3 + k; \
                if (t < TT && tt >= 0) xr[i][k] = *(const u32x4*)(GR + (size_t)(m0 + tt) * 2048 + 1024 + n * 64 + gq * 8); \
                else if (t < TT && smp) { const float* sp = st_conv + (size_t)(tt + 3) * D + gq * 8; const f32x4 a = *(const f32x4*)sp, bq = *(const f32x4*)(sp + 4); \
                    xr[i][k].x = pk2(a[0], a[1]); xr[i][k].y = pk2(a[2], a[3]); xr[i][k].z = pk2(bq[0], bq[1]); xr[i][k].w = pk2(bq[2], bq[3]); } \
                else xr[i][k] = (u32x4){0u, 0u, 0u, 0u}; } } } while (0)
        LRU_LOAD_REC(0);
        for (int ck = 0; ck < nch; ++ck) {
            const int t0 = ck << 7;
#pragma unroll
            for (int i = 0; i < 2; ++i) { const int item = tid + 512 * i, tl = item >> 3, gq = item & 7, t = t0 + tl;
                gtv[i] = (t < TT) ? *(const u32x4*)(GR + (size_t)(m0 + t) * 2048 + n * 64 + gq * 8) : (u32x4){0u, 0u, 0u, 0u}; }
#pragma unroll
            for (int i = 0; i < 2; ++i) {
                const int item = tid + 512 * i, tl = item >> 3, gq = item & 7, t = t0 + tl;
                float c[8];
                if (t < TT) {
                    float x3[8];
#pragma unroll
                    for (int e = 0; e < 8; ++e) c[e] = par[4 * 64 + gq * 8 + e];
#pragma unroll
                    for (int k = 0; k < 4; ++k) {
                        float xv[8]; unpack8(xr[i][k], xv);
#pragma unroll
                        for (int e = 0; e < 8; ++e) c[e] += par[k * 64 + gq * 8 + e] * xv[e];
                        if (k == 3) {
#pragma unroll
                            for (int e = 0; e < 8; ++e) x3[e] = xv[e]; }
                    }
                    if (t >= TT - 3) { float* o = out_c + (size_t)(t - (TT - 3)) * D + gq * 8;
                        *(f32x4*)o = (f32x4){x3[0], x3[1], x3[2], x3[3]}; *(f32x4*)(o + 4) = (f32x4){x3[4], x3[5], x3[6], x3[7]}; }
                } else {
#pragma unroll
                    for (int e = 0; e < 8; ++e) c[e] = 0.f;
                }
                *(LAS f32x4*)(sB + tl * 64 + gq * 8) = (f32x4){c[0], c[1], c[2], c[3]};
                *(LAS f32x4*)(sB + tl * 64 + gq * 8 + 4) = (f32x4){c[4], c[5], c[6], c[7]};
                *(LAS u32x4*)(sCb + tl * 144 + gq * 16) = pack8(c);
            }
            if (ck + 1 < nch) LRU_LOAD_REC(t0 + 128);
            __syncthreads();
            {
                const int l16 = lane & 15, q4 = lane >> 4;
                bf16x8 af[2];
#pragma unroll
                for (int ks = 0; ks < 2; ++ks) af[ks] = *(const LAS bf16x8*)(sCb + (16 * wave + l16) * 144 + (ks * 32 + q4 * 8) * 2);
#pragma unroll
                for (int nt = 0; nt < 4; ++nt) {
                    f32x4 ar = {0.f, 0.f, 0.f, 0.f}, ai = {0.f, 0.f, 0.f, 0.f};
#pragma unroll
                    for (int ks = 0; ks < 2; ++ks) {
                        const bf16x8 b1 = *(const LAS bf16x8*)(sWr + (16 * nt + l16) * 144 + (ks * 32 + q4 * 8) * 2);
                        const bf16x8 b2 = *(const LAS bf16x8*)(sWi + (16 * nt + l16) * 144 + (ks * 32 + q4 * 8) * 2);
                        ar = MFMA16(af[ks], b1, ar); ai = MFMA16(af[ks], b2, ai);
                    }
                    const int e = 16 * nt + l16; const float br_ = par[5 * 64 + e], bi_ = par[6 * 64 + e], cl = par[7 * 64 + e];
#pragma unroll
                    for (int j = 0; j < 4; ++j) {
                        const int tl = 16 * wave + 4 * q4 + j;
                        const float r = sigmoidf_(ar[j] + br_), ig = sigmoidf_(ai[j] + bi_), la = r * cl;
                        const float a = fexp2(la * LOG2E), x2 = 2.0f * la;
                        const float em_s = -x2 * (1.0f + x2 * (0.5f + x2 * (0.16666667f + x2 * (0.041666668f + x2 * 0.0083333338f)))), em_l = 1.0f - a * a;
                        const float bt = __builtin_amdgcn_sqrtf(x2 > -0.25f ? em_s : em_l) * ig * sB[tl * 64 + e];
                        sA[tl * 64 + e] = a; sB[tl * 64 + e] = bt;
                    }
                }
            }
            __syncthreads();
            {
                const int ch = tid & 63, seg = wave;
                float Aacc = 1.f, Bacc = 0.f;
#pragma unroll
                for (int k = 0; k < 16; ++k) { const int tl = 16 * seg + k; const float a = sA[tl * 64 + ch], bq = sB[tl * 64 + ch]; Bacc = a * Bacc + bq; Aacc *= a; }
                segA[seg * 64 + ch] = Aacc; segB[seg * 64 + ch] = Bacc;
                __syncthreads();
                float h = carry[ch];
                for (int s = 0; s < seg; ++s) h = segA[s * 64 + ch] * h + segB[s * 64 + ch];
#pragma unroll
                for (int k = 0; k < 16; ++k) { const int tl = 16 * seg + k; h = sA[tl * 64 + ch] * h + sB[tl * 64 + ch]; sB[tl * 64 + ch] = h; }
                __syncthreads();
                if (seg == 7) carry[ch] = h;
            }
#pragma unroll
            for (int i = 0; i < 2; ++i) {
                const int item = tid + 512 * i, tl = item >> 3, gq = item & 7, t = t0 + tl;
                if (t < TT) {
                    float g[8], o[8]; unpack8(gtv[i], g);
                    const f32x4 h0 = *(const LAS f32x4*)(sB + tl * 64 + gq * 8), h1 = *(const LAS f32x4*)(sB + tl * 64 + gq * 8 + 4);
                    const float h[8] = {h0[0], h0[1], h0[2], h0[3], h1[0], h1[1], h1[2], h1[3]};
#pragma unroll
                    for (int e = 0; e < 8; ++e) o[e] = h[e] * gelu_tanh(g[e]);
                    *(u32x4*)(HG + (size_t)(m0 + t) * 1024 + n * 64 + gq * 8) = pack8(o);
                    if (t == TT - 1) { *(f32x4*)(out_h + gq * 8) = h0; *(f32x4*)(out_h + gq * 8 + 4) = h1; }
                }
            }
            __syncthreads();
        }
    }
}

DI void ffn_fix_phase(PP pp, int layer, int tid) {
    bf16_t* H = (bf16_t*)(pp->ws + WS_BIG);
    const bf16_t* EG = (const bf16_t*)(pp->ws + WS_BIG + (size_t)M * 6144);
    const bf16_t* EU = EG + (size_t)(M / 16) * 4 * 3072;
    const float* cw = pp->in[26] + (size_t)layer * 3 * DFF; const float* cb = pp->in[27] + (size_t)layer * DFF;
    float* outp = pp->out;
    const int gt = obid() * 512 + tid, NT = ogrid() * 512;
    for (int it = gt; it < (M / 16) * 384; it += NT) {
        const int grp = it / 384, j0 = (it - grp * 384) * 8;
        const bool smp = grp >= MP / 16; int b, t0;
        if (!smp) { b = grp >> 7; t0 = (grp & 127) << 4; } else { b = grp - MP / 16; t0 = 0; }
        const u32x4 e0 = *(const u32x4*)(EG + ((size_t)grp * 4 + 0) * 3072 + j0), e1 = *(const u32x4*)(EG + ((size_t)grp * 4 + 1) * 3072 + j0),
                    e2 = *(const u32x4*)(EG + ((size_t)grp * 4 + 2) * 3072 + j0), e3 = *(const u32x4*)(EG + ((size_t)grp * 4 + 3) * 3072 + j0),
                    q0 = *(const u32x4*)(EU + ((size_t)grp * 2 + 0) * 3072 + j0), q1 = *(const u32x4*)(EU + ((size_t)grp * 2 + 1) * 3072 + j0);
        float w0[8], w1[8], w2[8], bb[8], gm2[8], gm1[8], g0[8], g1[8], u0[8], u1[8], h0[8], h1[8];
        { const f32x4 a = *(const f32x4*)(cw + j0), a2 = *(const f32x4*)(cw + j0 + 4), b1 = *(const f32x4*)(cw + DFF + j0), b2 = *(const f32x4*)(cw + DFF + j0 + 4),
                      c1 = *(const f32x4*)(cw + 2 * DFF + j0), c2 = *(const f32x4*)(cw + 2 * DFF + j0 + 4), d1 = *(const f32x4*)(cb + j0), d2 = *(const f32x4*)(cb + j0 + 4);
#pragma unroll
          for (int e = 0; e < 4; ++e) { w0[e] = a[e]; w0[e + 4] = a2[e]; w1[e] = b1[e]; w1[e + 4] = b2[e]; w2[e] = c1[e]; w2[e + 4] = c2[e]; bb[e] = d1[e]; bb[e + 4] = d2[e]; } }
        if (t0 > 0) { unpack8(*(const u32x4*)(EG + ((size_t)(grp - 1) * 4 + 0) * 3072 + j0), gm2); unpack8(*(const u32x4*)(EG + ((size_t)(grp - 1) * 4 + 1) * 3072 + j0), gm1); }
        else if (smp) { const float* sp = pp->in[4] + (size_t)(layer * DB + b) * 2 * DFF + j0;
            const f32x4 a = *(const f32x4*)sp, a2 = *(const f32x4*)(sp + 4), c1 = *(const f32x4*)(sp + DFF), c2 = *(const f32x4*)(sp + DFF + 4);
#pragma unroll
            for (int e = 0; e < 4; ++e) { gm2[e] = a[e]; gm2[e + 4] = a2[e]; gm1[e] = c1[e]; gm1[e + 4] = c2[e]; } }
        else {
#pragma unroll
            for (int e = 0; e < 8; ++e) { gm1[e] = 0.f; gm2[e] = 0.f; } }
        unpack8(e2, g0); unpack8(e3, g1); unpack8(q0, u0); unpack8(q1, u1);
#pragma unroll
        for (int e = 0; e < 8; ++e) {
            h0[e] = gelu_tanh(bb[e] + w0[e] * gm2[e] + w1[e] * gm1[e] + w2[e] * g0[e]) * u0[e];
            h1[e] = gelu_tanh(bb[e] + w0[e] * gm1[e] + w1[e] * g0[e] + w2[e] * g1[e]) * u1[e];
        }
        *(u32x4*)(H + (size_t)grp * 16 * 3072 + j0) = pack8(h0);
        *(u32x4*)(H + ((size_t)grp * 16 + 1) * 3072 + j0) = pack8(h1);
        if (smp || t0 == T - 16) {
            float* o = outp + (smp ? O_SF + (size_t)(layer * DB + b) * 2 * DFF : O_PF + (size_t)(layer * NB + b) * 2 * DFF) + j0;
            float s0[8], s1[8]; unpack8(e0, s0); unpack8(e1, s1);
            *(f32x4*)o = (f32x4){s0[0], s0[1], s0[2], s0[3]}; *(f32x4*)(o + 4) = (f32x4){s0[4], s0[5], s0[6], s0[7]};
            *(f32x4*)(o + DFF) = (f32x4){s1[0], s1[1], s1[2], s1[3]}; *(f32x4*)(o + DFF + 4) = (f32x4){s1[4], s1[5], s1[6], s1[7]};
        }
    }
}

DI void headnorm_phase(PP pp, int lane, int wave) {
    bf16_t* QKV = (bf16_t*)(pp->ws + WS_BIG);
    const float* kn = pp->in[19]; const float* qn = pp->in[22];
    const int gw = obid() * 8 + wave, NGW = ogrid() * 8;
    float* outp = pp->out;
    f32x4 kg[2][2], qg[2][2];
#pragma unroll
    for (int it = 0; it < 2; ++it) { const int d0 = ((it * 64 + lane) * 8) & 127;
        kg[it][0] = *(const f32x4*)(kn + d0); kg[it][1] = *(const f32x4*)(kn + d0 + 4); qg[it][0] = *(const f32x4*)(qn + d0) * QSCALE; qg[it][1] = *(const f32x4*)(qn + d0 + 4) * QSCALE; }
    for (int m2 = gw * 2; m2 < M; m2 += NGW * 2) {
        u32x4 kr[2][2], vr[2][2], qr[2][2];
#pragma unroll
        for (int r = 0; r < 2; ++r)
#pragma unroll
            for (int it = 0; it < 2; ++it) { const bf16_t* rp = QKV + (size_t)(m2 + r) * 3072 + (it * 64 + lane) * 8;
                kr[r][it] = *(const u32x4*)rp; vr[r][it] = *(const u32x4*)(rp + 1024); qr[r][it] = *(const u32x4*)(rp + 2048); }
#pragma unroll
        for (int r = 0; r < 2; ++r) {
            const int m = m2 + r;
            bf16_t* row = QKV + (size_t)m * 3072;
            float* ok = m < MP ? outp + O_PK + (size_t)m * D : outp + O_SK + (size_t)(m - MP) * D;
            float* ov = m < MP ? outp + O_PV + (size_t)m * D : outp + O_SV + (size_t)(m - MP) * D;
#pragma unroll
            for (int it = 0; it < 2; ++it) {
                const int col = (it * 64 + lane) * 8;
                float f[8]; float s;
                unpack8(kr[r][it], f); s = 0.f;
#pragma unroll
                for (int e = 0; e < 8; ++e) s += f[e] * f[e];
                s += __shfl_xor(s, 1); s += __shfl_xor(s, 2); s += __shfl_xor(s, 4); s += __shfl_xor(s, 8);
                float rs = __builtin_amdgcn_rsqf(s * (1.f / 128.f) + EPS);
#pragma unroll
                for (int e = 0; e < 4; ++e) { f[e] = f[e] * rs * kg[it][0][e]; f[e + 4] = f[e + 4] * rs * kg[it][1][e]; }
                *(f32x4*)(ok + col) = (f32x4){f[0], f[1], f[2], f[3]}; *(f32x4*)(ok + col + 4) = (f32x4){f[4], f[5], f[6], f[7]};
                *(u32x4*)(row + col) = pack8(f);
                unpack8(vr[r][it], f);
                *(f32x4*)(ov + col) = (f32x4){f[0], f[1], f[2], f[3]}; *(f32x4*)(ov + col + 4) = (f32x4){f[4], f[5], f[6], f[7]};
                unpack8(qr[r][it], f); s = 0.f;
#pragma unroll
                for (int e = 0; e < 8; ++e) s += f[e] * f[e];
                s += __shfl_xor(s, 1); s += __shfl_xor(s, 2); s += __shfl_xor(s, 4); s += __shfl_xor(s, 8);
                rs = __builtin_amdgcn_rsqf(s * (1.f / 128.f) + EPS);
#pragma unroll
                for (int e = 0; e < 4; ++e) { f[e] = f[e] * rs * qg[it][0][e]; f[e + 4] = f[e + 4] * rs * qg[it][1][e]; }
                *(u32x4*)(row + 2048 + col) = pack8(f);
            }
        }
    }
}

constexpr int AT_KP = 272, AT_VP = 136, AT_KB = 64 * AT_KP, AT_VB = 128 * AT_VP, AT_BUF = AT_KB + AT_VB, AT_FLAGS = 2 * AT_BUF;
template <bool SMP>
DI void attn_unit(PP pp, LAS unsigned char* lds, int tid, int lane, int wave, int b, int h, int qb) {
    const bf16_t* QKV = (const bf16_t*)(pp->ws + WS_BIG);
    bf16_t* AO = (bf16_t*)(pp->ws + WS_BIG + (size_t)M * 3072 * 2);
    const int mrow0 = SMP ? MP + b * DT : b * T;
    const int qpos0 = SMP ? PAST : qb * 256;
    const int qrow0 = SMP ? mrow0 : mrow0 + qb * 256;
    const int nq = SMP ? DT : 256;
    const int ntiles = SMP ? (PAST + DT - 2) / 64 + 1 : 4 * qb + 4;
    const int q = lane & 31, hl = lane >> 5, wq0 = 32 * wave;
    const bool wave_valid = wq0 < nq;
    const int myq = wq0 + q; const bool qvalid = myq < nq; const int qpos = qpos0 + myq; const int p_lo = qpos0 + wq0;
    LAS unsigned* sAlive = (LAS unsigned*)(lds + AT_FLAGS);
    bf16x8 qf[8];
    { const bf16_t* qp = QKV + (size_t)(qrow0 + (qvalid ? myq : 0)) * 3072 + 2048 + h * 128 + hl * 8;
#pragma unroll
      for (int s = 0; s < 8; ++s) qf[s] = *(const bf16x8*)(qp + s * 16); }
    f32x16 O[4];
#pragma unroll
    for (int dt = 0; dt < 4; ++dt)
#pragma unroll
        for (int j = 0; j < 16; ++j) O[dt][j] = 0.f;
    float R = 1.f; int wlive = 1;
    const float* ck = pp->in[5]; const float* cv = pp->in[6];
    u32x4 kr[2], vr[2];
#define AT_LOAD(kt_) do { if (!SMP) { _Pragma("unroll") for (int i = 0; i < 2; ++i) { const int c = tid + 512 * i, kl = c >> 4, part = c & 15, s = 64 * (kt_) + kl; \
        const bf16_t* rp = QKV + (size_t)(mrow0 + s) * 3072 + h * 128 + part * 8; kr[i] = *(const u32x4*)rp; vr[i] = *(const u32x4*)(rp + 1024); } } } while (0)
#define AT_STORE(buf_, kt_) do { LAS unsigned char* sK_ = lds + (buf_) * AT_BUF; LAS unsigned char* sV_ = sK_ + AT_KB; \
        _Pragma("unroll") for (int i = 0; i < 2; ++i) { const int c = tid + 512 * i, kl = c >> 4, part = c & 15; u32x4 kk, vv; \
            if (!SMP) { kk = kr[i]; vv = vr[i]; } \
            else { const int s = 64 * (kt_) + kl; \
                if (s < PAST) { const size_t off = (((size_t)b * PAST + s) * NH + h) * HD + part * 8; \
                    const f32x4 k0 = *(const f32x4*)(ck + off), k1 = *(const f32x4*)(ck + off + 4), v0 = *(const f32x4*)(cv + off), v1 = *(const f32x4*)(cv + off + 4); \
                    kk.x = pk2(k0[0], k0[1]); kk.y = pk2(k0[2], k0[3]); kk.z = pk2(k1[0], k1[1]); kk.w = pk2(k1[2], k1[3]); \
                    vv.x = pk2(v0[0], v0[1]); vv.y = pk2(v0[2], v0[3]); vv.z = pk2(v1[0], v1[1]); vv.w = pk2(v1[2], v1[3]); } \
                else if (s < PAST + DT) { const bf16_t* rp = QKV + (size_t)(mrow0 + s - PAST) * 3072 + h * 128 + part * 8; kk = *(const u32x4*)rp; vv = *(const u32x4*)(rp + 1024); } \
                else { kk = (u32x4){0u, 0u, 0u, 0u}; vv = kk; } } \
            *(LAS u32x4*)(sK_ + kl * AT_KP + part * 16) = kk; \
            LAS unsigned short* vp = (LAS unsigned short*)(sV_ + (part * 8) * AT_VP + kl * 2); \
            vp[0 * (AT_VP / 2)] = (unsigned short)(vv.x & 0xffffu); vp[1 * (AT_VP / 2)] = (unsigned short)(vv.x >> 16); \
            vp[2 * (AT_VP / 2)] = (unsigned short)(vv.y & 0xffffu); vp[3 * (AT_VP / 2)] = (unsigned short)(vv.y >> 16); \
            vp[4 * (AT_VP / 2)] = (unsigned short)(vv.z & 0xffffu); vp[5 * (AT_VP / 2)] = (unsigned short)(vv.z >> 16); \
            vp[6 * (AT_VP / 2)] = (unsigned short)(vv.w & 0xffffu); vp[7 * (AT_VP / 2)] = (unsigned short)(vv.w >> 16); } } while (0)

    AT_LOAD(ntiles - 1); AT_STORE(0, ntiles - 1);
    __syncthreads();
    int it = 0;
    for (int kt = ntiles - 1; kt >= 0; --kt, ++it) {
        if (kt > 0) AT_LOAD(kt - 1);
        const LAS unsigned char* sK = lds + (it & 1) * AT_BUF; const LAS unsigned char* sVt = sK + AT_KB;
        if (wave_valid && wlive) {
#pragma unroll
            for (int sub = 1; sub >= 0; --sub) {
                const int kbase = 64 * kt + 32 * sub;
                if (kbase <= p_lo + 30) {
                    f32x16 S;
#pragma unroll
                    for (int j = 0; j < 16; ++j) S[j] = 0.f;
#pragma unroll
                    for (int s = 0; s < 8; ++s) { const bf16x8 kf = *(const LAS bf16x8*)(sK + (32 * sub + q) * AT_KP + s * 32 + hl * 16); S = MFMA32(kf, qf[s], S); }
                    float sg[16];
                    if (kbase + 31 >= p_lo) {
#pragma unroll
                        for (int j = 0; j < 16; ++j) {
                            const int key = kbase + 8 * (j >> 2) + 4 * hl + (j & 3);
                            const float v = frcp(1.0f + fexp2(S[j]));
                            sg[j] = key >= qpos ? 1.0f : v;
                        }
                    } else {
#pragma unroll
                        for (int j = 0; j < 16; ++j) sg[j] = frcp(1.0f + fexp2(S[j]));
                    }
                    float Gq[4], pr[4], Tg[4];
#pragma unroll
                    for (int g = 0; g < 4; ++g) { const float gp = (sg[4 * g] * sg[4 * g + 1]) * (sg[4 * g + 2] * sg[4 * g + 3]); Gq[g] = __shfl_xor(gp, 32); pr[g] = gp * Gq[g]; }
                    Tg[3] = 1.f; Tg[2] = pr[3]; Tg[1] = pr[3] * pr[2]; Tg[0] = Tg[1] * pr[1];
                    float w[16];
#pragma unroll
                    for (int g = 0; g < 4; ++g) {
                        float P = R * Tg[g]; if (hl == 0) P *= Gq[g];
                        w[4 * g + 3] = (1.0f - sg[4 * g + 3]) * P; P *= sg[4 * g + 3];
                        w[4 * g + 2] = (1.0f - sg[4 * g + 2]) * P; P *= sg[4 * g + 2];
                        w[4 * g + 1] = (1.0f - sg[4 * g + 1]) * P; P *= sg[4 * g + 1];
                        w[4 * g] = (1.0f - sg[4 * g]) * P;
                    }
                    R = R * Tg[0] * pr[0];
#pragma unroll
                    for (int ks = 0; ks < 2; ++ks) {
                        u32x4 wp; wp.x = pk2(w[8 * ks], w[8 * ks + 1]); wp.y = pk2(w[8 * ks + 2], w[8 * ks + 3]); wp.z = pk2(w[8 * ks + 4], w[8 * ks + 5]); wp.w = pk2(w[8 * ks + 6], w[8 * ks + 7]);
                        const bf16x8 wf = __builtin_bit_cast(bf16x8, wp);
#pragma unroll
                        for (int dt = 0; dt < 4; ++dt) {
                            const LAS unsigned char* vp = sVt + (32 * dt + q) * AT_VP + (32 * sub + 16 * ks + 4 * hl) * 2;
                            const u32x2 v0 = *(const LAS u32x2*)vp, v1 = *(const LAS u32x2*)(vp + 16);
                            const u32x4 vv = {v0.x, v0.y, v1.x, v1.y};
                            O[dt] = MFMA32(__builtin_bit_cast(bf16x8, vv), wf, O[dt]);
                        }
                    }
                }
            }
        }
        {
            const bool started = wave_valid && (64 * kt <= p_lo + 30);
            const unsigned long long bal = __ballot(qvalid && R != 0.f);
            const unsigned alive = wave_valid ? ((!started || bal != 0ull) ? 1u : 0u) : 0u;
            wlive = __builtin_amdgcn_readfirstlane((int)alive);
            if (lane == 0) sAlive[(it & 1) * 8 + wave] = alive;
        }
        if (kt > 0) AT_STORE((it + 1) & 1, kt - 1);
        __syncthreads();
        unsigned any = 0;
#pragma unroll
        for (int w8 = 0; w8 < 8; ++w8) any |= sAlive[(it & 1) * 8 + w8];
        if (!any) break;
    }
#undef AT_LOAD
#undef AT_STORE
    if (wave_valid && qvalid) {
        bf16_t* orow = AO + (size_t)(qrow0 + myq) * 1024 + h * 128 + 4 * hl;
#pragma unroll
        for (int dt = 0; dt < 4; ++dt)
#pragma unroll
            for (int g = 0; g < 4; ++g) { u32x2 w; w.x = pk2(O[dt][4 * g], O[dt][4 * g + 1]); w.y = pk2(O[dt][4 * g + 2], O[dt][4 * g + 3]); *(u32x2*)(orow + 32 * dt + 8 * g) = w; }
    }
}
DI void attn_phase(PP pp, LAS unsigned char* lds, int tid, int lane, int wave) {
    for (int u = obid(); u < 128 + 2048; u += ogrid()) {
        if (u < 128) attn_unit<true>(pp, lds, tid, lane, wave, u >> 3, u & 7, 0);
        else { const int v = u - 128, qb = 7 - (v >> 8), rem = v & 255; attn_unit<false>(pp, lds, tid, lane, wave, rem >> 3, rem & 7, qb); }
        __syncthreads();
    }
}

DI void final_phase(PP pp, int lane, int wave) {
    const int gw = obid() * 8 + wave, NGW = ogrid() * 8; const float* gn = pp->in[29];
    const bf16_t* XB = (const bf16_t*)(pp->ws + WS_XB);
    f32x4 gv[4];
#pragma unroll
    for (int j = 0; j < 4; ++j) gv[j] = *((const f32x4*)gn + lane + 64 * j);
    float* outp = pp->out;
    for (int m4 = gw * 4; m4 < M; m4 += NGW * 4) {
        u32x2 raw[4][4];
#pragma unroll
        for (int r = 0; r < 4; ++r)
#pragma unroll
            for (int j = 0; j < 4; ++j) raw[r][j] = *((const u32x2*)(XB + (size_t)(m4 + r) * D) + lane + 64 * j);
#pragma unroll
        for (int r = 0; r < 4; ++r) {
            f32x4 v[4]; float s = 0.f;
#pragma unroll
            for (int j = 0; j < 4; ++j) { v[j] = (f32x4){bflo(raw[r][j].x), bfhi(raw[r][j].x), bflo(raw[r][j].y), bfhi(raw[r][j].y)};
                s += (v[j][0] * v[j][0] + v[j][1] * v[j][1]) + (v[j][2] * v[j][2] + v[j][3] * v[j][3]); }
            const float rstd = __builtin_amdgcn_rsqf(wave_sum(s) * (1.f / D) + EPS);
#pragma unroll
            for (int j = 0; j < 4; ++j) *((f32x4*)(outp + (size_t)(m4 + r) * D) + lane + 64 * j) = v[j] * rstd * gv[j];
        }
    }
}

#define XB_TMO      128
#define XB_XCNT(j)  (256  + 64 * (j))
#define XB_XSUB(j)  (1280 + 64 * (j))
#define XB_XGEN(j)  (2304 + 64 * (j))
#define XB_TOP      3328
#define XB_TOPGEN   3392
#define XCD_BAR_WORDS 3456
#define XB_SPIN_CAP (1u << 18)

__device__ __forceinline__ unsigned xb_ld(unsigned* p)              { return __hip_atomic_load(p, __ATOMIC_RELAXED, __HIP_MEMORY_SCOPE_AGENT); }
__device__ __forceinline__ unsigned xb_add(unsigned* p, unsigned v) { return __hip_atomic_fetch_add(p, v, __ATOMIC_RELAXED, __HIP_MEMORY_SCOPE_AGENT); }
__device__ __forceinline__ unsigned xb_xcc_id() { return (unsigned)__builtin_amdgcn_s_getreg((3 << 11) | 20) & 0xFu; }
#define XB_SPIN(cond, bar) do { unsigned _sp = 0; while (cond) { __builtin_amdgcn_s_sleep(1); \
    if ((++_sp & 255u) == 0u) { if (xb_ld(&(bar)[XB_TMO])) break; if (_sp > XB_SPIN_CAP) { atomicAdd(&(bar)[XB_TMO], 1u); break; } } } } while (0)

struct XcdBarrier {
    unsigned* bar; unsigned x;
    volatile LAS unsigned* st;
};

__device__ __forceinline__ XcdBarrier xcd_barrier_post(unsigned* bar, volatile LAS unsigned* st) {
    XcdBarrier b; b.bar = bar; b.x = xb_xcc_id(); b.st = st;
    if (threadIdx.x == 0) (void)xb_add(&bar[XB_XCNT(b.x)], 1u);
    return b;
}
__device__ __forceinline__ void xcd_barrier_complete(unsigned* bar, unsigned x, unsigned& nloc, unsigned& nx) {
    const unsigned G = gridDim.x * gridDim.y * gridDim.z;
    unsigned sum, cnt, mine, sp = 0u;
    for (;;) {
        sum = 0u; cnt = 0u; mine = 0u;
#pragma unroll
        for (unsigned j = 0; j < 16; ++j) { const unsigned c = xb_ld(&bar[XB_XCNT(j)]); sum += c; cnt += (c > 0u) ? 1u : 0u; mine = (j == x) ? c : mine; }
        if (sum == G) break;
        __builtin_amdgcn_s_sleep(1);
        if ((++sp & 255u) == 0u) { if (xb_ld(&bar[XB_TMO])) break; if (sp > XB_SPIN_CAP) { atomicAdd(&bar[XB_TMO], 1u); break; } }
    }
    nloc = mine > 0u ? mine : 1u; nx = cnt > 0u ? cnt : 1u;
}

__device__ __forceinline__ void xcd_barrier(const XcdBarrier& b) {
    asm volatile("s_waitcnt vmcnt(0)" ::: "memory");
    __syncthreads();
    if (threadIdx.x == 0) {
        unsigned* bar = b.bar;
        __builtin_amdgcn_s_waitcnt(0);
        unsigned nloc = b.st[0], nx = b.st[1];
        if (nloc == 0u) { xcd_barrier_complete(bar, b.x, nloc, nx); b.st[0] = nloc; b.st[1] = nx; }
        const unsigned old = xb_add(&bar[XB_XSUB(b.x)], 1u);
        const unsigned gen = old / nloc;
        if (old + 1u == (gen + 1u) * nloc) {
            __builtin_amdgcn_fence(__ATOMIC_RELEASE, "agent");
            asm volatile("s_waitcnt vmcnt(0)" ::: "memory");
            const unsigned og = xb_add(&bar[XB_TOP], 1u);
            const unsigned tg = og / nx;
            if (og + 1u == (tg + 1u) * nx) xb_add(&bar[XB_TOPGEN], 1u);
            else XB_SPIN(xb_ld(&bar[XB_TOPGEN]) == tg, bar);
            __builtin_amdgcn_fence(__ATOMIC_ACQUIRE, "agent");
            xb_add(&bar[XB_XGEN(b.x)], 1u);
            asm volatile("s_waitcnt vmcnt(0)" ::: "memory");
        } else {
            XB_SPIN(xb_ld(&bar[XB_XGEN(b.x)]) == gen, bar);
            __builtin_amdgcn_fence(__ATOMIC_ACQUIRE, "agent");
            asm volatile("s_waitcnt vmcnt(0)" ::: "memory");
        }
    }
    __syncthreads();
}

__global__ void __launch_bounds__(512, 2) fwd_kernel(Params p) {
    extern __shared__ __attribute__((aligned(16))) unsigned char lds_raw[];
    LAS unsigned char* lds = (LAS unsigned char*)lds_raw;
    cg::grid_group grid = cg::this_grid();
    constexpr int LDS_ST = 143360;
    { const int t0_ = otid(); if (t0_ < 2) ((LAS unsigned*)(lds + LDS_ST))[t0_] = 0u; __syncthreads();
      PP pp0 = (PP)__builtin_amdgcn_kernarg_segment_ptr(); (void)xcd_barrier_post((unsigned*)(pp0->ws + WS_CW), (volatile LAS unsigned*)(lds + LDS_ST)); }
#pragma unroll 1
    for (int ph = 0; ph < 15; ++ph) {
        if (ph == 8) continue;
        const int tid = otid(), lane = tid & 63, wave = __builtin_amdgcn_readfirstlane(tid >> 6), bid = obid(), nblk = ogrid();
        PP pp = (PP)__builtin_amdgcn_kernarg_segment_ptr();
        asm volatile("" : "+s"(pp));
        unsigned char* ws = pp->ws;
        bf16_t* XB = (bf16_t*)(ws + WS_XB); float* SS = (float*)(ws + WS_SS); bf16_t* BIG = (bf16_t*)(ws + WS_BIG);
        float* X = pp->out;
        if (ph == 4 || ph == 11) {
            const int layer = ph == 4 ? 0 : 1;
            const bf16_t* Bt = (const bf16_t*)(ws + (layer ? WS_WUP1 : WS_WUP0));
            pg8::Gemm g{XB, Bt, M, 6144, 1024, 1024}; pg8::StaticOrder S; S.init(M, 6144, nblk, bid);
            bf16_t* EGp = BIG + (size_t)M * 3072;
            pg8::EpiFfn E{BIG, EGp, EGp + (size_t)(M / 16) * 4 * 3072, SS, pp->in[26] + (size_t)layer * 3 * DFF, pp->in[27] + (size_t)layer * DFF};
            pg8::gemm_phase<pg8::EpiFfn, pg8::StaticOrder, true, false>(lds, g, S, E);
        } else if (ph == 7) {
            pg8::Gemm g{XB, (const bf16_t*)(ws + WS_WQKV), M, 3072, 1024, 1024}; pg8::StaticOrder S; S.init(M, 3072, nblk, bid);
            pg8::EpiQkv E{BIG, X, SS, pp->in[19], pp->in[22], (LAS float*)(lds + 131072), O_PK, O_PV, O_SK, O_SV, MP, QSCALE};
            pg8::gemm_phase<pg8::EpiQkv, pg8::StaticOrder, true, false>(lds, g, S, E);
        } else if (ph == 1) {
            const bf16_t* Bt; int N; const float* ss = SS;
            { Bt = (const bf16_t*)(ws + WS_WIN); N = 2048; }
            pg8::Gemm g{XB, Bt, M, N, 1024, 1024}; pg8::StaticOrder S; S.init(M, N, nblk, bid);
            pg8::EpiScaleBf16 E{BIG, N, ss};
#if !defined(NO_GS)
            pg8::gemm_phase<pg8::EpiScaleBf16, pg8::StaticOrder, true, false>(lds, g, S, E);
#endif
#if defined(PROBE_GS2)
            grid.sync(); pg8::gemm_phase<pg8::EpiScaleBf16, pg8::StaticOrder, true, false>(lds, g, S, E);
#endif
        } else if (ph == 3 || ph == 6 || ph == 10 || ph == 13) {
            const bf16_t* A; const bf16_t* Bt; int K, lda;
            if (ph == 3) { A = BIG + (size_t)M * 2048; lda = 1024; K = 1024; Bt = (const bf16_t*)(ws + WS_WOUT); }
            else if (ph == 6) { A = BIG; lda = 3072; K = 3072; Bt = (const bf16_t*)(ws + WS_WDN0); }
            else if (ph == 10) { A = BIG + (size_t)M * 3072; lda = 1024; K = 1024; Bt = (const bf16_t*)(ws + WS_WO); }
            else { A = BIG; lda = 3072; K = 3072; Bt = (const bf16_t*)(ws + WS_WDN1); }
            pg8::Gemm g{A, Bt, M, 1024, K, lda}; pg8::StaticOrder S; S.init(M, 1024, nblk, bid);
            pg8::EpiResid E{XB, SS};
#if !defined(NO_GR)
            pg8::gemm_phase<pg8::EpiResid, pg8::StaticOrder, true, false>(lds, g, S, E);
#endif
        }
#if !defined(NO_P0)
        else if (ph == 0) phase0(pp, lds, lane, wave);
#endif
#if !defined(NO_LRU)
        else if (ph == 2) {
#if defined(PROBE_L2)
            _Pragma("unroll 1") for (int rep = 0; rep < 2; ++rep) { if (rep) grid.sync(); lru_phase(pp, lds, tid, lane, wave); }
#else
            lru_phase(pp, lds, tid, lane, wave);
#endif
        }
#endif
#if !defined(NO_ACT)
        else if (ph == 5 || ph == 12) ffn_fix_phase(pp, ph == 5 ? 0 : 1, tid);
#endif
#if !defined(NO_HN)
        else if (ph == 8) headnorm_phase(pp, lane, wave);
#endif
#if !defined(NO_ATT)
        else if (ph == 9) {
#if defined(PROBE_A2)
            _Pragma("unroll 1") for (int rep = 0; rep < 2; ++rep) { if (rep) grid.sync(); attn_phase(pp, lds, tid, lane, wave); }
#else
            attn_phase(pp, lds, tid, lane, wave);
#endif
        }
#endif
#if !defined(NO_FIN)
        else if (ph == 14) final_phase(pp, lane, wave);
#endif
        if (ph == 0) grid.sync();
        else if (ph < 14) { XcdBarrier xb; xb.bar = (unsigned*)(ws + WS_CW); xb.x = xb_xcc_id(); xb.st = (volatile LAS unsigned*)(lds + LDS_ST); xcd_barrier(xb); }
    }
}

extern "C" void kernel_launch(void* const* d_in, const int* in_sizes, int n_in, void* d_out, int out_size, void* d_ws, size_t ws_size, hipStream_t stream) {
    static int grid = 0;
    if (grid == 0) {
        if (n_in != 30 || (size_t)out_size != O_END || ws_size < WS_END) { fprintf(stderr, "kernel_launch: unexpected shapes n_in %d out %d ws %zu (need %zu)\n", n_in, out_size, ws_size, (size_t)WS_END); grid = -1; return; }
        int dev = 0, cus = 0, per_cu = 0;
        hipGetDevice(&dev); hipDeviceGetAttribute(&cus, hipDeviceAttributeMultiprocessorCount, dev);
        if (hipFuncSetAttribute((const void*)fwd_kernel, hipFuncAttributeMaxDynamicSharedMemorySize, LDS_BYTES) != hipSuccess) { fprintf(stderr, "kernel_launch: hipFuncSetAttribute failed\n"); grid = -1; return; }
        if (hipOccupancyMaxActiveBlocksPerMultiprocessor(&per_cu, (const void*)fwd_kernel, 512, LDS_BYTES) != hipSuccess || per_cu < 1) { fprintf(stderr, "kernel_launch: occupancy query failed (%d)\n", per_cu); per_cu = 1; }
        (void)hipGetLastError();
        grid = cus * per_cu;
    }
    if (grid < 0) return;
    if (hipMemsetAsync((char*)d_ws + WS_CW, 0, CW_BYTES, stream) != hipSuccess) { fprintf(stderr, "kernel_launch: memset of the barrier words failed\n"); return; }
    Params p{};
    for (int i = 0; i < 30; ++i) p.in[i] = (const float*)d_in[i];
    p.out = (float*)d_out; p.ws = (unsigned char*)d_ws;
    void* args[] = {&p};
    hipError_t e = hipLaunchCooperativeKernel((const void*)fwd_kernel, dim3(grid), dim3(512), args, LDS_BYTES, stream);
    if (e != hipSuccess) fprintf(stderr, "cooperative launch failed: %s (grid %d)\n", hipGetErrorString(e), grid);
}
```

```cpp
#include <hip/hip_runtime.h>
#include <hip/hip_cooperative_groups.h>
#include <cstdio>
#include <cstdint>
namespace cg = cooperative_groups;

#define DI __device__ __forceinline__
#define LAS __attribute__((address_space(3)))

constexpr int D = 1024, NB = 32, T = 2048, DB = 16, DT = 16, PAST = 4096, NH = 8, HD = 128, DFF = 3072, NBLK = 16, BLK = 64;
constexpr int MP = NB * T, MS = DB * DT, M = MP + MS;
constexpr float EPS = 1e-6f;
constexpr float LOG2E = 1.4426950408889634f;
constexpr float QSCALE = 0.08838834764831845f * LOG2E;

constexpr size_t O_YP = 0, O_YS = O_YP + (size_t)MP * D, O_PH = O_YS + (size_t)MS * D, O_PC = O_PH + (size_t)NB * D, O_PF = O_PC + (size_t)NB * 3 * D,
                 O_PK = O_PF + (size_t)2 * NB * 2 * DFF, O_PV = O_PK + (size_t)MP * D, O_SH = O_PV + (size_t)MP * D, O_SC = O_SH + (size_t)DB * D,
                 O_SF = O_SC + (size_t)DB * 3 * D, O_SK = O_SF + (size_t)2 * DB * 2 * DFF, O_SV = O_SK + (size_t)MS * D, O_END = O_SV + (size_t)MS * D;
static_assert(O_END == 202899456ull, "output size");

constexpr size_t MiB = 1u << 20;
constexpr size_t WS_WIN = 0, WS_WOUT = 4 * MiB, WS_WUP0 = 6 * MiB, WS_WUP1 = 18 * MiB, WS_WDN0 = 30 * MiB, WS_WDN1 = 36 * MiB, WS_WQKV = 42 * MiB, WS_WO = 48 * MiB,
                 WS_WRT = 50 * MiB, WS_WIT = 50 * MiB + 128 * 1024, WS_SS = 52 * MiB, WS_CW = 57 * MiB  , CW_BYTES = 16 * 1024, WS_XB = 58 * MiB, WS_BIG = 187 * MiB, WS_END = WS_BIG + (size_t)M * 6144 * 2;
static_assert(WS_XB + (size_t)M * D * 2 <= WS_BIG && WS_SS + (size_t)M * 16 * 4 <= WS_XB && WS_END <= 1024 * MiB, "ws map");

constexpr int LDS_BYTES = 147456;

typedef unsigned short bf16_t;
typedef float f32x2 __attribute__((ext_vector_type(2)));
typedef float f32x4 __attribute__((ext_vector_type(4)));
typedef float f32x16 __attribute__((ext_vector_type(16)));
typedef short bf16x8 __attribute__((ext_vector_type(8)));
typedef short s16x4 __attribute__((ext_vector_type(4)));
typedef unsigned u32x4 __attribute__((ext_vector_type(4)));
typedef unsigned u32x2 __attribute__((ext_vector_type(2)));
typedef __bf16 bf16x2_t __attribute__((ext_vector_type(2)));

DI unsigned pk2(float lo, float hi) { f32x2 v = {lo, hi}; bf16x2_t b = __builtin_convertvector(v, bf16x2_t); return __builtin_bit_cast(unsigned, b); }
DI float bflo(unsigned u) { return __uint_as_float(u << 16); }
DI float bfhi(unsigned u) { return __uint_as_float(u & 0xffff0000u); }
DI void unpack8(const u32x4 v, float (&f)[8]) { f[0] = bflo(v.x); f[1] = bfhi(v.x); f[2] = bflo(v.y); f[3] = bfhi(v.y); f[4] = bflo(v.z); f[5] = bfhi(v.z); f[6] = bflo(v.w); f[7] = bfhi(v.w); }
DI u32x4 pack8(const float (&f)[8]) { u32x4 w; w.x = pk2(f[0], f[1]); w.y = pk2(f[2], f[3]); w.z = pk2(f[4], f[5]); w.w = pk2(f[6], f[7]); return w; }
DI float fexp2(float x) { return __builtin_amdgcn_exp2f(x); }
DI float frcp(float x) { return __builtin_amdgcn_rcpf(x); }
DI float sigmoidf_(float x) { return frcp(1.0f + fexp2(-x * LOG2E)); }
DI float gelu_tanh(float x) { const float u = 0.7978845608028654f * (x + 0.044715f * x * x * x); return x * frcp(1.0f + fexp2(-2.0f * LOG2E * u)); }
DI float wave_sum(float v) {
#pragma unroll
    for (int o = 1; o < 64; o <<= 1) v += __shfl_xor(v, o);
    return v;
}
namespace pg8 {
#define PG8_LAS __attribute__((address_space(3)))
typedef unsigned short bf16_t;
typedef short bf16x8 __attribute__((ext_vector_type(8)));
typedef float f32x4 __attribute__((ext_vector_type(4)));
typedef unsigned u32x4 __attribute__((ext_vector_type(4)));
constexpr int BM = 256, BK = 64, HALF = 128, HTB = HALF * BK * 2  , STAGE_BYTES = 8 * HTB, NXCD = 8, WGM = 8;

__host__ __device__ __forceinline__ int lds_byte(int r, int c) { const int st = (r >> 4) * 2 + (c >> 5), rr = r & 15, cc = c & 31, ob = rr * 64 + cc * 2; return st * 1024 + (ob ^ (((ob >> 9) & 1) << 5)); }
__host__ __device__ __forceinline__ void stage_rc(int b, int& R, int& C) { const int st = b / 1024, sb = b % 1024, swz = sb ^ (((sb >> 9) & 1) << 5); R = (st >> 1) * 16 + swz / 64; C = (st & 1) * 32 + (swz % 64) / 2; }
__host__ __device__ __forceinline__ int perm32(int rho) { const int n = rho >> 4, i = rho & 15; return 8 * (i >> 2) + 4 * n + (i & 3); }

struct Unit { int pm, pn; };
struct Gemm { const bf16_t* A; const bf16_t* Bt; int M, N, K, lda; };

struct StaticOrder {
    int nM, nN, nwg, G, c;
    __host__ __device__ void init(int M, int N, int G_, int c_) { nM = M / BM; nN = N / BM; nwg = nM * nN; G = G_; c = c_; }
    __host__ __device__ bool next(int i, Unit& u) const {
        const long L = (long)i * G + c; if (L >= nwg) return false;
        int wgid = (int)L; { const int q = nwg / NXCD, r = nwg % NXCD, xcd = wgid % NXCD, off = wgid / NXCD; wgid = (xcd < r ? xcd * (q + 1) : r * (q + 1) + (xcd - r) * q) + off; }
        const int nig = WGM * nN, gid = wgid / nig, fm = gid * WGM, gsz = (nM - fm) < WGM ? (nM - fm) : WGM;
        u.pm = fm + ((wgid % nig) % gsz); u.pn = (wgid % nig) / gsz; return true;
    }
    __device__ __forceinline__ void a_ready(const Unit&) const {}
    __device__ __forceinline__ void done(const Unit&) const {}
};
__device__ __forceinline__ unsigned cvt_pk_bf16(float lo, float hi) { unsigned r; asm volatile("v_cvt_pk_bf16_f32 %0, %1, %2" : "=v"(r) : "v"(lo), "v"(hi)); return r; }
DI float row_rstd(const float* ss, int row) {
    const f32x4* p = (const f32x4*)(ss + (size_t)row * 16);
    const f32x4 a = p[0], b = p[1], c = p[2], d = p[3];
    const float s = ((a[0] + a[1]) + (a[2] + a[3])) + ((b[0] + b[1]) + (b[2] + b[3])) + ((c[0] + c[1]) + (c[2] + c[3])) + ((d[0] + d[1]) + (d[2] + d[3]));
    return __builtin_amdgcn_rsqf(s * (1.0f / 1024.0f) + 1e-6f);
}
struct EpiScaleBf16 {
    static constexpr bool PERM = true, AFTER_DRAIN = false;
    bf16_t* O; int ldc; const float* ss;
    DI void operator()(const f32x4 (&acc)[2][2][4][2], const Unit& u, int wr, int wc, int fr, int fq) const {
        const int row0 = u.pm * BM + wr * 64 + fr, col0 = u.pn * BM + wc * 32 + 8 * fq;
#pragma unroll
        for (int ai = 0; ai < 2; ++ai)
#pragma unroll
            for (int m = 0; m < 4; ++m) {
                const int row = row0 + ai * HALF + m * 16;
                const float sc = ss ? row_rstd(ss, row) : 1.0f;
                bf16_t* rowp = O + (size_t)row * ldc + col0;
#pragma unroll
                for (int bj = 0; bj < 2; ++bj) {
                    const f32x4 v0 = acc[ai][bj][m][0] * sc, v1 = acc[ai][bj][m][1] * sc;
                    u32x4 w; w.x = cvt_pk_bf16(v0[0], v0[1]); w.y = cvt_pk_bf16(v0[2], v0[3]); w.z = cvt_pk_bf16(v1[0], v1[1]); w.w = cvt_pk_bf16(v1[2], v1[3]);
                    *(u32x4*)(rowp + bj * HALF) = w;
                }
                if (m & 1) asm volatile("" ::: "memory");
            }
    }
};
struct EpiResid {
    static constexpr bool PERM = true, AFTER_DRAIN = false;
    bf16_t* XB; float* ss;
    DI void operator()(const f32x4 (&acc)[2][2][4][2], const Unit& u, int wr, int wc, int fr, int fq) const {
        const int row0 = u.pm * BM + wr * 64 + fr, col0 = u.pn * BM + wc * 32 + 8 * fq;
#pragma unroll
        for (int ai = 0; ai < 2; ++ai)
#pragma unroll
            for (int m = 0; m < 4; ++m) {
                const int row = row0 + ai * HALF + m * 16;
                bf16_t* xb = XB + (size_t)row * 1024 + col0;
                float sq = 0.f;
#pragma unroll
                for (int bj = 0; bj < 2; ++bj) {
                    const u32x4 r = *(const u32x4*)(xb + bj * HALF);
                    const f32x4 r0 = {__uint_as_float(r.x << 16), __uint_as_float(r.x & 0xffff0000u), __uint_as_float(r.y << 16), __uint_as_float(r.y & 0xffff0000u)};
                    const f32x4 r1 = {__uint_as_float(r.z << 16), __uint_as_float(r.z & 0xffff0000u), __uint_as_float(r.w << 16), __uint_as_float(r.w & 0xffff0000u)};
                    const f32x4 v0 = acc[ai][bj][m][0] + r0, v1 = acc[ai][bj][m][1] + r1;
                    u32x4 w; w.x = cvt_pk_bf16(v0[0], v0[1]); w.y = cvt_pk_bf16(v0[2], v0[3]); w.z = cvt_pk_bf16(v1[0], v1[1]); w.w = cvt_pk_bf16(v1[2], v1[3]);
                    *(u32x4*)(xb + bj * HALF) = w;
                    sq += (v0[0] * v0[0] + v0[1] * v0[1]) + (v0[2] * v0[2] + v0[3] * v0[3]) + (v1[0] * v1[0] + v1[1] * v1[1]) + (v1[2] * v1[2] + v1[3] * v1[3]);
                }
                sq += __shfl_xor(sq, 16); sq += __shfl_xor(sq, 32);
                if (fq == 0) ss[(size_t)row * 16 + u.pn * 4 + wc] = sq;
                if (m & 1) asm volatile("" ::: "memory");
            }
    }
};
struct EpiFfn {
    static constexpr bool PERM = true, AFTER_DRAIN = false;
    bf16_t* H; bf16_t* EG; bf16_t* EU; const float* ss; const float* cw; const float* cb;
    DI void operator()(const f32x4 (&acc)[2][2][4][2], const Unit& u, int wr, int wc, int fr, int fq) const {
        const int row0 = u.pm * BM + wr * 64 + fr, hc = u.pn * HALF + wc * 32 + 8 * fq;
        float w0[8], w1[8], w2[8], bb[8];
        { const f32x4 a0 = *(const f32x4*)(cw + hc), a1 = *(const f32x4*)(cw + hc + 4), b0 = *(const f32x4*)(cw + 3072 + hc), b1 = *(const f32x4*)(cw + 3072 + hc + 4),
                      c0 = *(const f32x4*)(cw + 6144 + hc), c1 = *(const f32x4*)(cw + 6144 + hc + 4), d0 = *(const f32x4*)(cb + hc), d1 = *(const f32x4*)(cb + hc + 4);
#pragma unroll
          for (int i = 0; i < 4; ++i) { w0[i] = a0[i]; w0[i + 4] = a1[i]; w1[i] = b0[i]; w1[i + 4] = b1[i]; w2[i] = c0[i]; w2[i + 4] = c1[i]; bb[i] = d0[i]; bb[i + 4] = d1[i]; } }
#pragma unroll
        for (int ai = 0; ai < 2; ++ai)
#pragma unroll
            for (int m = 0; m < 4; ++m) {
                const int row = row0 + ai * HALF + m * 16;
                const float sc = row_rstd(ss, row);
                float g[8], uu[8];
#pragma unroll
                for (int i = 0; i < 4; ++i) { g[i] = acc[ai][0][m][0][i] * sc; g[i + 4] = acc[ai][0][m][1][i] * sc; uu[i] = acc[ai][1][m][0][i] * sc; uu[i + 4] = acc[ai][1][m][1][i] * sc; }
                u32x4 hw; unsigned hp[4];
#pragma unroll
                for (int i = 0; i < 8; i += 2) {
                    const float pa1 = __shfl_up(g[i], 1, 16), pa2 = __shfl_up(g[i], 2, 16), pb1 = __shfl_up(g[i + 1], 1, 16), pb2 = __shfl_up(g[i + 1], 2, 16);
                    const float ca = bb[i] + w0[i] * pa2 + w1[i] * pa1 + w2[i] * g[i], cb2 = bb[i + 1] + w0[i + 1] * pb2 + w1[i + 1] * pb1 + w2[i + 1] * g[i + 1];
                    const float ua = 0.7978845608028654f * (ca + 0.044715f * ca * ca * ca), ub = 0.7978845608028654f * (cb2 + 0.044715f * cb2 * cb2 * cb2);
                    const float ha = ca * __builtin_amdgcn_rcpf(1.0f + __builtin_amdgcn_exp2f(-2.8853900817779268f * ua)) * uu[i];
                    const float hb = cb2 * __builtin_amdgcn_rcpf(1.0f + __builtin_amdgcn_exp2f(-2.8853900817779268f * ub)) * uu[i + 1];
                    hp[i >> 1] = cvt_pk_bf16(ha, hb);
                }
                hw.x = hp[0]; hw.y = hp[1]; hw.z = hp[2]; hw.w = hp[3];
                if (fr >= 2) *(u32x4*)(H + (size_t)row * 3072 + hc) = hw;
                if (fr >= 14 || fr < 2) {
                    u32x4 gw; gw.x = cvt_pk_bf16(g[0], g[1]); gw.y = cvt_pk_bf16(g[2], g[3]); gw.z = cvt_pk_bf16(g[4], g[5]); gw.w = cvt_pk_bf16(g[6], g[7]);
                    *(u32x4*)(EG + ((size_t)(row >> 4) * 4 + ((fr + 2) & 3)) * 3072 + hc) = gw;
                    if (fr < 2) { u32x4 uw; uw.x = cvt_pk_bf16(uu[0], uu[1]); uw.y = cvt_pk_bf16(uu[2], uu[3]); uw.z = cvt_pk_bf16(uu[4], uu[5]); uw.w = cvt_pk_bf16(uu[6], uu[7]);
                        *(u32x4*)(EU + ((size_t)(row >> 4) * 2 + fr) * 3072 + hc) = uw; }
                }
                asm volatile("" ::: "memory");
            }
    }
};

struct EpiQkv {
    static constexpr bool PERM = true, AFTER_DRAIN = false;
    bf16_t* O; float* outp; const float* ss; const float* kn; const float* qn; PG8_LAS float* part;
    size_t o_pk, o_pv, o_sk, o_sv; int mp; float qscale;
    DI void operator()(const f32x4 (&acc)[2][2][4][2], const Unit& u, int wr, int wc, int fr, int fq) const {
        const int kind = u.pn >> 2;
        const int row0 = u.pm * BM + wr * 64 + fr, col0 = u.pn * BM + wc * 32 + 8 * fq, hcol = (u.pn & 3) * BM + wc * 32 + 8 * fq;
        if (kind == 1) {
#pragma unroll
            for (int ai = 0; ai < 2; ++ai)
#pragma unroll
                for (int m = 0; m < 4; ++m) {
                    const int row = row0 + ai * HALF + m * 16;
                    const float sc = row_rstd(ss, row);
                    const size_t ob = (row < mp ? o_pv + (size_t)row * 1024 : o_sv + (size_t)(row - mp) * 1024) + hcol;
#pragma unroll
                    for (int bj = 0; bj < 2; ++bj) {
                        const f32x4 v0 = acc[ai][bj][m][0] * sc, v1 = acc[ai][bj][m][1] * sc;
                        *(f32x4*)(outp + ob + bj * HALF) = v0; *(f32x4*)(outp + ob + bj * HALF + 4) = v1;
                        u32x4 w; w.x = cvt_pk_bf16(v0[0], v0[1]); w.y = cvt_pk_bf16(v0[2], v0[3]); w.z = cvt_pk_bf16(v1[0], v1[1]); w.w = cvt_pk_bf16(v1[2], v1[3]);
                        *(u32x4*)(O + (size_t)row * 3072 + col0 + bj * HALF) = w;
                    }
                    if (m & 1) asm volatile("" ::: "memory");
                }
            return;
        }
        float scr[2][4];
#pragma unroll
        for (int ai = 0; ai < 2; ++ai)
#pragma unroll
            for (int m = 0; m < 4; ++m) {
                const int rl = ai * HALF + wr * 64 + m * 16 + fr;
                const float sc = row_rstd(ss, u.pm * BM + rl); scr[ai][m] = sc;
#pragma unroll
                for (int bj = 0; bj < 2; ++bj) {
                    const f32x4 v0 = acc[ai][bj][m][0] * sc, v1 = acc[ai][bj][m][1] * sc;
                    float s = (v0[0] * v0[0] + v0[1] * v0[1]) + (v0[2] * v0[2] + v0[3] * v0[3]) + (v1[0] * v1[0] + v1[1] * v1[1]) + (v1[2] * v1[2] + v1[3] * v1[3]);
                    s += __shfl_xor(s, 16); s += __shfl_xor(s, 32);
                    if (fq == 0) part[(rl * 2 + bj) * 4 + wc] = s;
                }
            }
        asm volatile("s_waitcnt lgkmcnt(0)" ::: "memory"); __builtin_amdgcn_s_barrier(); asm volatile("" ::: "memory");
        const float* gp = (kind == 0 ? kn : qn) + wc * 32 + 8 * fq;
        const float gm = kind == 0 ? 1.0f : qscale;
        const f32x4 g0 = *(const f32x4*)gp * gm, g1 = *(const f32x4*)(gp + 4) * gm;
#pragma unroll
        for (int ai = 0; ai < 2; ++ai)
#pragma unroll
            for (int m = 0; m < 4; ++m) {
                const int rl = ai * HALF + wr * 64 + m * 16 + fr, row = u.pm * BM + rl;
                const size_t ob = (row < mp ? o_pk + (size_t)row * 1024 : o_sk + (size_t)(row - mp) * 1024) + hcol;
#pragma unroll
                for (int bj = 0; bj < 2; ++bj) {
                    const f32x4 ps = *(const PG8_LAS f32x4*)(part + (rl * 2 + bj) * 4);
                    const float rs = __builtin_amdgcn_rsqf(((ps[0] + ps[1]) + (ps[2] + ps[3])) * (1.0f / 128.0f) + 1e-6f) * scr[ai][m];
                    const f32x4 v0 = acc[ai][bj][m][0] * rs * g0, v1 = acc[ai][bj][m][1] * rs * g1;
                    if (kind == 0) { *(f32x4*)(outp + ob + bj * HALF) = v0; *(f32x4*)(outp + ob + bj * HALF + 4) = v1; }
                    u32x4 w; w.x = cvt_pk_bf16(v0[0], v0[1]); w.y = cvt_pk_bf16(v0[2], v0[3]); w.z = cvt_pk_bf16(v1[0], v1[1]); w.w = cvt_pk_bf16(v1[2], v1[3]);
                    *(u32x4*)(O + (size_t)row * 3072 + col0 + bj * HALF) = w;
                }
                if (m & 1) asm volatile("" ::: "memory");
            }
    }
};
template <class Epi, class Sched, bool ALIGN_EPI = false, bool SP2 = false>
__device__ __forceinline__ void gemm_phase(PG8_LAS unsigned char* lds, const Gemm g, const Sched& S, const Epi& E) {
    int tid = threadIdx.x; asm volatile("" : "+v"(tid)); const int wid = __builtin_amdgcn_readfirstlane(tid >> 6), lane = tid & 63, wr = wid >> 2, wc = wid & 3, fr = lane & 15, fq = lane >> 4;
    const int K = g.K, nt = K / BK;
    unsigned voffA[2], voffB[2];
#pragma unroll
    for (int i = 0; i < 2; ++i) { int R, C; stage_rc(tid * 16 + i * 8192, R, C); const int Rb = Epi::PERM ? ((R & ~31) + perm32(R & 31)) : R;
        voffA[i] = (unsigned)(R * g.lda + C) * 2u; voffB[i] = (unsigned)(Rb * K + C) * 2u; }
    const size_t kstep = (size_t)(BK * 2);
    const size_t hstep = (size_t)HALF * K * 2;
    const size_t tstep = 2 * hstep; const size_t hstepA = (size_t)HALF * g.lda * 2, tstepA = 2 * hstepA;
    const unsigned ldsw = (unsigned)wid * 1024u;
    const int aoff = lds_byte(wr * 64 + fr, fq * 8), boff = lds_byte(wc * 32 + fr, fq * 8);
#define PG8_SA(b, h) (((b) * 2 + (h)) * HTB)
#define PG8_SB(b, h) ((4 + (b) * 2 + (h)) * HTB)
#define PG8_STAGE(bufoff, gbase, voff) do { _Pragma("unroll") for (int _i = 0; _i < 2; ++_i) \
        __builtin_amdgcn_global_load_lds((const unsigned*)((const char*)(gbase) + (voff)[_i]), (PG8_LAS unsigned*)(lds + (bufoff) + ldsw + _i * 8192), 16, 0, 0); } while (0)
#define PG8_LDA(dst, b, h) do { _Pragma("unroll") for (int m = 0; m < 4; ++m) _Pragma("unroll") for (int k = 0; k < 2; ++k) dst[m][k] = *(const PG8_LAS bf16x8*)(lds + PG8_SA(b, h) + aoff + m * 2048 + k * 1024); } while (0)
#define PG8_LDB(dst, b, h) do { _Pragma("unroll") for (int n = 0; n < 2; ++n) _Pragma("unroll") for (int k = 0; k < 2; ++k) dst[n][k] = *(const PG8_LAS bf16x8*)(lds + PG8_SB(b, h) + boff + n * 2048 + k * 1024); } while (0)
#define PG8_MMA(ai, bj, At, Bt) do { __builtin_amdgcn_s_setprio(1); _Pragma("unroll") for (int m = 0; m < 4; ++m) _Pragma("unroll") for (int n = 0; n < 2; ++n) _Pragma("unroll") for (int k = 0; k < 2; ++k) \
        acc[ai][bj][m][n] = __builtin_amdgcn_mfma_f32_16x16x32_bf16(Bt[n][k], At[m][k], acc[ai][bj][m][n], 0, 0, 0); __builtin_amdgcn_s_setprio(0); } while (0)
#define PG8_WAIT_V(n) asm volatile("s_waitcnt vmcnt(" #n ")" ::: "memory")
#define PG8_WAIT_L(n) asm volatile("s_waitcnt lgkmcnt(" #n ")" ::: "memory")
#define PG8_BAR __builtin_amdgcn_s_barrier()
#define PG8_SCHED __builtin_amdgcn_sched_barrier(0)
    Unit cur, nxt; int ui = 0;
    if (!S.next(0, cur)) return;
    f32x4 acc[2][2][4][2];
#pragma unroll
    for (int a = 0; a < 2; ++a)
#pragma unroll
        for (int b = 0; b < 2; ++b)
#pragma unroll
            for (int m = 0; m < 4; ++m)
#pragma unroll
                for (int n = 0; n < 2; ++n) acc[a][b][m][n] = (f32x4){0.f, 0.f, 0.f, 0.f};
    bf16x8 At[4][2], B0[2][2], B1[2][2];
    const char* cA = (const char*)g.A + (size_t)cur.pm * tstepA; const char* cB = (const char*)g.Bt + (size_t)cur.pn * tstep;
    S.a_ready(cur);
    if constexpr (SP2) {
        PG8_STAGE(PG8_SB(0, 0), cB, voffB); PG8_STAGE(PG8_SB(0, 1), cB + hstep, voffB); PG8_STAGE(PG8_SA(0, 0), cA, voffA); PG8_STAGE(PG8_SA(0, 1), cA + hstepA, voffA);
        if (wr == 1) PG8_BAR;
        PG8_WAIT_V(2); PG8_BAR;
        PG8_STAGE(PG8_SB(1, 0), cB + kstep, voffB); PG8_STAGE(PG8_SA(1, 0), cA + kstep, voffA); PG8_STAGE(PG8_SB(1, 1), cB + hstep + kstep, voffB);
        PG8_WAIT_V(6); PG8_BAR;
    } else {
        PG8_STAGE(PG8_SB(0, 0), cB, voffB); PG8_STAGE(PG8_SA(0, 0), cA, voffA); PG8_STAGE(PG8_SB(0, 1), cB + hstep, voffB); PG8_STAGE(PG8_SA(0, 1), cA + hstepA, voffA);
        if (wr == 1) PG8_BAR;
        PG8_WAIT_V(4); PG8_BAR;
        PG8_STAGE(PG8_SB(1, 0), cB + kstep, voffB); PG8_STAGE(PG8_SA(1, 0), cA + kstep, voffA); PG8_STAGE(PG8_SB(1, 1), cB + hstep + kstep, voffB);
        PG8_WAIT_V(6); PG8_BAR;
    }
    for (;;) {
        const bool has_next = S.next(ui + 1, nxt);
        const char* nA = has_next ? (const char*)g.A + (size_t)nxt.pm * tstepA : cA; const char* nB = has_next ? (const char*)g.Bt + (size_t)nxt.pn * tstep : cB;
        for (int t = 0; t < nt; t += 2) {
            const bool last = (t == nt - 2);
            const char* a1 = cA + (size_t)(t + 1) * kstep;
            const char* a2 = last ? nA : cA + (size_t)(t + 2) * kstep; const char* b2 = last ? nB : cB + (size_t)(t + 2) * kstep;
            const char* a3 = a2 + kstep; const char* b3 = b2 + kstep;
            if (last && has_next) S.a_ready(nxt);
            if constexpr (SP2) {
            PG8_LDB(B0, 0, 0); PG8_LDB(B1, 0, 1); PG8_SCHED; PG8_LDA(At, 0, 0); PG8_STAGE(PG8_SA(1, 1), a1 + hstepA, voffA);
            PG8_WAIT_V(8); PG8_WAIT_L(0); PG8_BAR; PG8_MMA(0, 0, At, B0); PG8_MMA(0, 1, At, B1); PG8_BAR; PG8_SCHED;
            PG8_LDA(At, 0, 1); PG8_STAGE(PG8_SB(0, 0), b2, voffB); PG8_STAGE(PG8_SB(0, 1), b2 + hstep, voffB); PG8_STAGE(PG8_SA(0, 0), a2, voffA);
            PG8_WAIT_V(8); PG8_WAIT_L(0); PG8_BAR; PG8_MMA(1, 0, At, B0); PG8_MMA(1, 1, At, B1); PG8_BAR; PG8_SCHED;
            PG8_LDB(B0, 1, 0); PG8_LDB(B1, 1, 1); PG8_SCHED; PG8_LDA(At, 1, 0); PG8_STAGE(PG8_SA(0, 1), a2 + hstepA, voffA);
            PG8_WAIT_V(8); PG8_WAIT_L(0); PG8_BAR; PG8_MMA(0, 0, At, B0); PG8_MMA(0, 1, At, B1); PG8_BAR; PG8_SCHED;
            PG8_LDA(At, 1, 1); PG8_STAGE(PG8_SB(1, 0), b3, voffB); PG8_STAGE(PG8_SB(1, 1), b3 + hstep, voffB); PG8_STAGE(PG8_SA(1, 0), a3, voffA);
            PG8_WAIT_V(8); PG8_WAIT_L(0); PG8_BAR; PG8_MMA(1, 0, At, B0); PG8_MMA(1, 1, At, B1); PG8_BAR; PG8_SCHED;
            } else {
            PG8_LDB(B0, 0, 0); PG8_SCHED; PG8_LDA(At, 0, 0); PG8_STAGE(PG8_SA(1, 1), a1 + hstepA, voffA);
            PG8_WAIT_L(8); PG8_BAR; PG8_WAIT_L(0); PG8_MMA(0, 0, At, B0); PG8_BAR; PG8_SCHED;
            PG8_LDB(B1, 0, 1); PG8_STAGE(PG8_SB(0, 0), b2, voffB);
            PG8_BAR; PG8_WAIT_L(0); PG8_MMA(0, 1, At, B1); PG8_BAR;
            PG8_LDA(At, 0, 1); PG8_STAGE(PG8_SA(0, 0), a2, voffA);
            PG8_BAR; PG8_WAIT_L(0); PG8_MMA(1, 0, At, B0); PG8_BAR; PG8_SCHED;
            PG8_STAGE(PG8_SB(0, 1), b2 + hstep, voffB);
            PG8_WAIT_V(6); PG8_BAR; PG8_MMA(1, 1, At, B1); PG8_BAR;
            PG8_LDB(B0, 1, 0); PG8_SCHED; PG8_LDA(At, 1, 0); PG8_STAGE(PG8_SA(0, 1), a2 + hstepA, voffA);
            PG8_WAIT_L(8); PG8_BAR; PG8_WAIT_L(0); PG8_MMA(0, 0, At, B0); PG8_BAR; PG8_SCHED;
            PG8_LDB(B1, 1, 1); PG8_STAGE(PG8_SB(1, 0), b3, voffB);
            PG8_BAR; PG8_WAIT_L(0); PG8_MMA(0, 1, At, B1); PG8_BAR;
            PG8_LDA(At, 1, 1); PG8_STAGE(PG8_SA(1, 0), a3, voffA);
            PG8_BAR; PG8_WAIT_L(0); PG8_MMA(1, 0, At, B0); PG8_BAR; PG8_SCHED;
            PG8_STAGE(PG8_SB(1, 1), b3 + hstep, voffB);
            PG8_WAIT_V(6); PG8_BAR; PG8_MMA(1, 1, At, B1); PG8_BAR;
            }
        }
        if constexpr (ALIGN_EPI) { if (wr == 0) PG8_BAR; }
        if constexpr (!Epi::AFTER_DRAIN) { E(acc, cur, wr, wc, fr, fq); S.done(cur); }
        if (!has_next) break;
#pragma unroll
        for (int a = 0; a < 2; ++a)
#pragma unroll
            for (int b = 0; b < 2; ++b)
#pragma unroll
                for (int m = 0; m < 4; ++m)
#pragma unroll
                    for (int n = 0; n < 2; ++n) acc[a][b][m][n] = (f32x4){0.f, 0.f, 0.f, 0.f};
        cur = nxt; cA = nA; cB = nB; ++ui;
        if constexpr (ALIGN_EPI) { if (wr == 1) PG8_BAR; }
    }
    PG8_WAIT_V(0);
    if constexpr (!ALIGN_EPI) { if (wr == 0) PG8_BAR; }
    PG8_BAR;
    if constexpr (Epi::AFTER_DRAIN) { E.fused(acc, cur, wr, wc, fr, fq, lds, wid, lane); S.done(cur); }
#undef PG8_SA
#undef PG8_SB
#undef PG8_STAGE
#undef PG8_LDA
#undef PG8_LDB
#undef PG8_MMA
#undef PG8_WAIT_V
#undef PG8_WAIT_L
#undef PG8_BAR
#undef PG8_SCHED
}
}

struct Params { const float* in[30]; float* out; unsigned char* ws; };
typedef const __attribute__((address_space(4))) Params* PP;

DI int otid() { int t = threadIdx.x; asm volatile("" : "+v"(t)); return t; }
DI int obid() { int t = blockIdx.x; asm volatile("" : "+s"(t)); return t; }
DI int ogrid() { int t = gridDim.x; asm volatile("" : "+s"(t)); return t; }
#define LDS_WAIT() asm volatile("s_waitcnt lgkmcnt(0)" ::: "memory")
#define MFMA16(a, b, c) __builtin_amdgcn_mfma_f32_16x16x32_bf16((a), (b), (c), 0, 0, 0)
#define MFMA32(a, b, c) __builtin_amdgcn_mfma_f32_32x32x16_bf16((a), (b), (c), 0, 0, 0)

template <bool FFN_PERM = false>
DI void p0_transpose_item(const float* W, const float* gk, int K, int N, bf16_t* WT, int row_off, LAS float* scr, int item, int lane) {
    const int nblk = N / 32, kb = item / nblk, nb = item % nblk, k0 = 64 * kb, n0 = 32 * nb;
    if (FFN_PERM) { const int j = n0 < 3072 ? n0 : n0 - 3072; row_off = (j >> 7) * 256 + (n0 < 3072 ? 0 : 128) + (j & 127) - n0; }
#pragma unroll 8
    for (int i = 0; i < 32; ++i) { const int kk = 2 * i + (lane >> 5); const float gv = gk ? gk[k0 + kk] : 1.0f; scr[kk * 33 + (lane & 31)] = __builtin_nontemporal_load(&W[(size_t)(k0 + kk) * N + n0 + (lane & 31)]) * gv; }
    LDS_WAIT(); asm volatile("" ::: "memory");
    const int c = lane & 7;
#pragma unroll
    for (int j = 0; j < 4; ++j) { const int n = (lane >> 3) + 8 * j; const LAS float* s = scr + (8 * c) * 33 + n;
        u32x4 o; o.x = pk2(s[0 * 33], s[1 * 33]); o.y = pk2(s[2 * 33], s[3 * 33]); o.z = pk2(s[4 * 33], s[5 * 33]); o.w = pk2(s[6 * 33], s[7 * 33]);
        *(u32x4*)(WT + (size_t)(row_off + n0 + n) * K + k0 + 8 * c) = o; }
    LDS_WAIT(); asm volatile("" ::: "memory");
}
DI void phase0(PP pp, LAS unsigned char* lds, int lane, int wave) {
    LAS float* scr = (LAS float*)(lds + wave * 16384);
    const int gw = obid() * 8 + wave, NGW = ogrid() * 8;
    unsigned char* ws = pp->ws;
    for (int it = gw; it < 12864; it += NGW) {
        int r = it;
        if (r < 1024) { p0_transpose_item(pp->in[8], pp->in[7], 1024, 2048, (bf16_t*)(ws + WS_WIN), 0, scr, r, lane); continue; } r -= 1024;
        if (r < 512) { p0_transpose_item(pp->in[16], nullptr, 1024, 1024, (bf16_t*)(ws + WS_WOUT), 0, scr, r, lane); continue; } r -= 512;
        if (r < 3072) { p0_transpose_item<true>(pp->in[25], pp->in[24], 1024, 6144, (bf16_t*)(ws + WS_WUP0), 0, scr, r, lane); continue; } r -= 3072;
        if (r < 3072) { p0_transpose_item<true>(pp->in[25] + (size_t)1024 * 6144, pp->in[24] + 1024, 1024, 6144, (bf16_t*)(ws + WS_WUP1), 0, scr, r, lane); continue; } r -= 3072;
        if (r < 1536) { p0_transpose_item(pp->in[28], nullptr, 3072, 1024, (bf16_t*)(ws + WS_WDN0), 0, scr, r, lane); continue; } r -= 1536;
        if (r < 1536) { p0_transpose_item(pp->in[28] + (size_t)3072 * 1024, nullptr, 3072, 1024, (bf16_t*)(ws + WS_WDN1), 0, scr, r, lane); continue; } r -= 1536;
        if (r < 1024) { p0_transpose_item(pp->in[18], pp->in[17], 1024, 2048, (bf16_t*)(ws + WS_WQKV), 0, scr, r, lane); continue; } r -= 1024;
        if (r < 512) { p0_transpose_item(pp->in[21], pp->in[20], 1024, 1024, (bf16_t*)(ws + WS_WQKV), 2048, scr, r, lane); continue; } r -= 512;
        if (r < 512) { p0_transpose_item(pp->in[23], nullptr, 1024, 1024, (bf16_t*)(ws + WS_WO), 0, scr, r, lane); continue; } r -= 512;
        if (r < 32) { const int blk = r >> 1; p0_transpose_item(pp->in[11] + blk * 4096, nullptr, 64, 64, (bf16_t*)(ws + WS_WRT) + blk * 4096, 0, scr, r & 1, lane); continue; } r -= 32;
        { const int blk = r >> 1; p0_transpose_item(pp->in[13] + blk * 4096, nullptr, 64, 64, (bf16_t*)(ws + WS_WIT) + blk * 4096, 0, scr, r & 1, lane); }
    }
    bf16_t* XB = (bf16_t*)(ws + WS_XB);
    float* SSp = (float*)(ws + WS_SS);
    for (int m4 = gw * 4; m4 < M; m4 += NGW * 4) {
        const float* xbase = m4 < MP ? pp->in[0] + (size_t)m4 * D : pp->in[1] + (size_t)(m4 - MP) * D;
        f32x4 v[4][4];
#pragma unroll
        for (int r = 0; r < 4; ++r)
#pragma unroll
            for (int j = 0; j < 4; ++j) v[r][j] = __builtin_nontemporal_load((const f32x4*)(xbase + (size_t)r * D) + lane + 64 * j);
#pragma unroll
        for (int r = 0; r < 4; ++r) {
            float s = 0.f;
            u32x2* o8 = (u32x2*)(XB + (size_t)(m4 + r) * D) + lane;
#pragma unroll
            for (int j = 0; j < 4; ++j) { s += (v[r][j][0] * v[r][j][0] + v[r][j][1] * v[r][j][1]) + (v[r][j][2] * v[r][j][2] + v[r][j][3] * v[r][j][3]);
                u32x2 w; w.x = pk2(v[r][j][0], v[r][j][1]); w.y = pk2(v[r][j][2], v[r][j][3]); o8[64 * j] = w; }
            s = wave_sum(s);
            if (lane < 4) *((f32x4*)(SSp + (size_t)(m4 + r) * 16) + lane) = (f32x4){lane == 0 ? s : 0.f, 0.f, 0.f, 0.f};
        }
    }
}

DI void lru_phase(PP pp, LAS unsigned char* lds, int tid, int lane, int wave) {
    const bf16_t* GR = (const bf16_t*)(pp->ws + WS_BIG);
    bf16_t* HG = (bf16_t*)(pp->ws + WS_BIG + (size_t)M * 2048 * 2);
    const bf16_t* WRT = (const bf16_t*)(pp->ws + WS_WRT); const bf16_t* WIT = (const bf16_t*)(pp->ws + WS_WIT);
    LAS unsigned char* sWr = lds; LAS unsigned char* sWi = lds + 9216; LAS unsigned char* sCb = lds + 18432;
    LAS float* sA = (LAS float*)(lds + 36864); LAS float* sB = (LAS float*)(lds + 69632);
    LAS float* segA = (LAS float*)(lds + 102400); LAS float* segB = (LAS float*)(lds + 104448);
    LAS float* carry = (LAS float*)(lds + 106496); LAS float* par = (LAS float*)(lds + 106752);
#if defined(PROBE_L2B)
    for (int unit_ = obid(); unit_ < 1536; unit_ += ogrid()) { const int unit = unit_ >= 768 ? unit_ - 768 : unit_;
#else
    for (int unit = obid(); unit < 768; unit += ogrid()) {
#endif
        const bool smp = unit >= 512; const int su = smp ? unit - 512 : unit; const int b = su >> 4, n = su & 15;
        const int m0 = smp ? MP + b * DT : b * T; const int TT = smp ? DT : T;
        float* out_h = pp->out + (smp ? O_SH : O_PH) + (size_t)b * D + n * 64;
        float* out_c = pp->out + (smp ? O_SC : O_PC) + (size_t)b * 3 * D + n * 64;
        const float* st_conv = pp->in[3] + (size_t)b * 3 * D + n * 64;
        if (tid < 64) {
            const int ch = n * 64 + tid;
#pragma unroll
            for (int k = 0; k < 4; ++k) par[k * 64 + tid] = pp->in[9][k * 1024 + ch];
            par[4 * 64 + tid] = pp->in[10][ch]; par[5 * 64 + tid] = pp->in[12][ch]; par[6 * 64 + tid] = pp->in[14][ch];
            const float lam = pp->in[15][ch];
            par[7 * 64 + tid] = 8.0f * (fminf(lam, 0.f) - log1pf(expf(-fabsf(lam))));
            carry[tid] = smp ? pp->in[2][(size_t)b * D + ch] : 0.f;
        }
        { const int row = tid >> 3, ck = tid & 7;
          *(LAS u32x4*)(sWr + row * 144 + ck * 16) = *(const u32x4*)(WRT + n * 4096 + row * 64 + ck * 8);
          *(LAS u32x4*)(sWi + row * 144 + ck * 16) = *(const u32x4*)(WIT + n * 4096 + row * 64 + ck * 8); }
        __syncthreads();
        const int nch = (TT + 127) >> 7;
        u32x4 xr[2][4], gtv[2];
#define LRU_LOAD_REC(t0_) do { _Pragma("unroll") for (int i = 0; i < 2; ++i) { const int item = tid + 512 * i, tl = item >> 3, gq = item & 7, t = (t0_) + tl; \
            _Pragma("unroll") for (int k = 0; k < 4; ++k) { const int tt = t - 3 + k; \
                if (t < TT && tt >= 0) xr[i][k] = *(const u32x4*)(GR + (size_t)(m0 + tt) * 2048 + 1024 + n * 64 + gq * 8); \
                else if (t < TT && smp) { const float* sp = st_conv + (size_t)(tt + 3) * D + gq * 8; const f32x4 a = *(const f32x4*)sp, bq = *(const f32x4*)(sp + 4); \
                    xr[i][k].x = pk2(a[0], a[1]); xr[i][k].y = pk2(a[2], a[3]); xr[i][k].z = pk2(bq[0], bq[1]); xr[i][k].w = pk2(bq[2], bq[3]); } \
                else xr[i][k] = (u32x4){0u, 0u, 0u, 0u}; } } } while (0)
        LRU_LOAD_REC(0);
        for (int ck = 0; ck < nch; ++ck) {
            const int t0 = ck << 7;
#pragma unroll
            for (int i = 0; i < 2; ++i) { const int item = tid + 512 * i, tl = item >> 3, gq = item & 7, t = t0 + tl;
                gtv[i] = (t < TT) ? *(const u32x4*)(GR + (size_t)(m0 + t) * 2048 + n * 64 + gq * 8) : (u32x4){0u, 0u, 0u, 0u}; }
#pragma unroll
            for (int i = 0; i < 2; ++i) {
                const int item = tid + 512 * i, tl = item >> 3, gq = item & 7, t = t0 + tl;
                float c[8];
                if (t < TT) {
                    float x3[8];
#pragma unroll
                    for (int e = 0; e < 8; ++e) c[e] = par[4 * 64 + gq * 8 + e];
#pragma unroll
                    for (int k = 0; k < 4; ++k) {
                        float xv[8]; unpack8(xr[i][k], xv);
#pragma unroll
                        for (int e = 0; e < 8; ++e) c[e] += par[k * 64 + gq * 8 + e] * xv[e];
                        if (k == 3) {
#pragma unroll
                            for (int e = 0; e < 8; ++e) x3[e] = xv[e]; }
                    }
                    if (t >= TT - 3) { float* o = out_c + (size_t)(t - (TT - 3)) * D + gq * 8;
                        *(f32x4*)o = (f32x4){x3[0], x3[1], x3[2], x3[3]}; *(f32x4*)(o + 4) = (f32x4){x3[4], x3[5], x3[6], x3[7]}; }
                } else {
#pragma unroll
                    for (int e = 0; e < 8; ++e) c[e] = 0.f;
                }
                *(LAS f32x4*)(sB + tl * 64 + gq * 8) = (f32x4){c[0], c[1], c[2], c[3]};
                *(LAS f32x4*)(sB + tl * 64 + gq * 8 + 4) = (f32x4){c[4], c[5], c[6], c[7]};
                *(LAS u32x4*)(sCb + tl * 144 + gq * 16) = pack8(c);
            }
            if (ck + 1 < nch) LRU_LOAD_REC(t0 + 128);
            __syncthreads();
            {
                const int l16 = lane & 15, q4 = lane >> 4;
                bf16x8 af[2];
#pragma unroll
                for (int ks = 0; ks < 2; ++ks) af[ks] = *(const LAS bf16x8*)(sCb + (16 * wave + l16) * 144 + (ks * 32 + q4 * 8) * 2);
#pragma unroll
                for (int nt = 0; nt < 4; ++nt) {
                    f32x4 ar = {0.f, 0.f, 0.f, 0.f}, ai = {0.f, 0.f, 0.f, 0.f};
#pragma unroll
                    for (int ks = 0; ks < 2; ++ks) {
                        const bf16x8 b1 = *(const LAS bf16x8*)(sWr + (16 * nt + l16) * 144 + (ks * 32 + q4 * 8) * 2);
                        const bf16x8 b2 = *(const LAS bf16x8*)(sWi + (16 * nt + l16) * 144 + (ks * 32 + q4 * 8) * 2);
                        ar = MFMA16(af[ks], b1, ar); ai = MFMA16(af[ks], b2, ai);
                    }
                    const int e = 16 * nt + l16; const float br_ = par[5 * 64 + e], bi_ = par[6 * 64 + e], cl = par[7 * 64 + e];
#pragma unroll
                    for (int j = 0; j < 4; ++j) {
                        const int tl = 16 * wave + 4 * q4 + j;
                        const float r = sigmoidf_(ar[j] + br_), ig = sigmoidf_(ai[j] + bi_), la = r * cl;
                        const float a = fexp2(la * LOG2E), x2 = 2.0f * la;
                        const float em_s = -x2 * (1.0f + x2 * (0.5f + x2 * (0.16666667f + x2 * (0.041666668f + x2 * 0.0083333338f)))), em_l = 1.0f - a * a;
                        const float bt = __builtin_amdgcn_sqrtf(x2 > -0.25f ? em_s : em_l) * ig * sB[tl * 64 + e];
                        sA[tl * 64 + e] = a; sB[tl * 64 + e] = bt;
                    }
                }
            }
            __syncthreads();
            {
                const int ch = tid & 63, seg = wave;
                float Aacc = 1.f, Bacc = 0.f;
#pragma unroll
                for (int k = 0; k < 16; ++k) { const int tl = 16 * seg + k; const float a = sA[tl * 64 + ch], bq = sB[tl * 64 + ch]; Bacc = a * Bacc + bq; Aacc *= a; }
                segA[seg * 64 + ch] = Aacc; segB[seg * 64 + ch] = Bacc;
                __syncthreads();
                float h = carry[ch];
                for (int s = 0; s < seg; ++s) h = segA[s * 64 + ch] * h + segB[s * 64 + ch];
#pragma unroll
                for (int k = 0; k < 16; ++k) { const int tl = 16 * seg + k; h = sA[tl * 64 + ch] * h + sB[tl * 64 + ch]; sB[tl * 64 + ch] = h; }
                __syncthreads();
                if (seg == 7) carry[ch] = h;
            }
#pragma unroll
            for (int i = 0; i < 2; ++i) {
                const int item = tid + 512 * i, tl = item >> 3, gq = item & 7, t = t0 + tl;
                if (t < TT) {
                    float g[8], o[8]; unpack8(gtv[i], g);
                    const f32x4 h0 = *(const LAS f32x4*)(sB + tl * 64 + gq * 8), h1 = *(const LAS f32x4*)(sB + tl * 64 + gq * 8 + 4);
                    const float h[8] = {h0[0], h0[1], h0[2], h0[3], h1[0], h1[1], h1[2], h1[3]};
#pragma unroll
                    for (int e = 0; e < 8; ++e) o[e] = h[e] * gelu_tanh(g[e]);
                    *(u32x4*)(HG + (size_t)(m0 + t) * 1024 + n * 64 + gq * 8) = pack8(o);
                    if (t == TT - 1) { *(f32x4*)(out_h + gq * 8) = h0; *(f32x4*)(out_h + gq * 8 + 4) = h1; }
                }
            }
            __syncthreads();
        }
    }
}

DI void ffn_fix_phase(PP pp, int layer, int tid) {
    bf16_t* H = (bf16_t*)(pp->ws + WS_BIG);
    const bf16_t* EG = (const bf16_t*)(pp->ws + WS_BIG + (size_t)M * 6144);
    const bf16_t* EU = EG + (size_t)(M / 16) * 4 * 3072;
    const float* cw = pp->in[26] + (size_t)layer * 3 * DFF; const float* cb = pp->in[27] + (size_t)layer * DFF;
    float* outp = pp->out;
    const int gt = obid() * 512 + tid, NT = ogrid() * 512;
    for (int it = gt; it < (M / 16) * 384; it += NT) {
        const int grp = it / 384, j0 = (it - grp * 384) * 8;
        const bool smp = grp >= MP / 16; int b, t0;
        if (!smp) { b = grp >> 7; t0 = (grp & 127) << 4; } else { b = grp - MP / 16; t0 = 0; }
        const u32x4 e0 = *(const u32x4*)(EG + ((size_t)grp * 4 + 0) * 3072 + j0), e1 = *(const u32x4*)(EG + ((size_t)grp * 4 + 1) * 3072 + j0),
                    e2 = *(const u32x4*)(EG + ((size_t)grp * 4 + 2) * 3072 + j0), e3 = *(const u32x4*)(EG + ((size_t)grp * 4 + 3) * 3072 + j0),
                    q0 = *(const u32x4*)(EU + ((size_t)grp * 2 + 0) * 3072 + j0), q1 = *(const u32x4*)(EU + ((size_t)grp * 2 + 1) * 3072 + j0);
        float w0[8], w1[8], w2[8], bb[8], gm2[8], gm1[8], g0[8], g1[8], u0[8], u1[8], h0[8], h1[8];
        { const f32x4 a = *(const f32x4*)(cw + j0), a2 = *(const f32x4*)(cw + j0 + 4), b1 = *(const f32x4*)(cw + DFF + j0), b2 = *(const f32x4*)(cw + DFF + j0 + 4),
                      c1 = *(const f32x4*)(cw + 2 * DFF + j0), c2 = *(const f32x4*)(cw + 2 * DFF + j0 + 4), d1 = *(const f32x4*)(cb + j0), d2 = *(const f32x4*)(cb + j0 + 4);
#pragma unroll
          for (int e = 0; e < 4; ++e) { w0[e] = a[e]; w0[e + 4] = a2[e]; w1[e] = b1[e]; w1[e + 4] = b2[e]; w2[e] = c1[e]; w2[e + 4] = c2[e]; bb[e] = d1[e]; bb[e + 4] = d2[e]; } }
        if (t0 > 0) { unpack8(*(const u32x4*)(EG + ((size_t)(grp - 1) * 4 + 0) * 3072 + j0), gm2); unpack8(*(const u32x4*)(EG + ((size_t)(grp - 1) * 4 + 1) * 3072 + j0), gm1); }
        else if (smp) { const float* sp = pp->in[4] + (size_t)(layer * DB + b) * 2 * DFF + j0;
            const f32x4 a = *(const f32x4*)sp, a2 = *(const f32x4*)(sp + 4), c1 = *(const f32x4*)(sp + DFF), c2 = *(const f32x4*)(sp + DFF + 4);
#pragma unroll
            for (int e = 0; e < 4; ++e) { gm2[e] = a[e]; gm2[e + 4] = a2[e]; gm1[e] = c1[e]; gm1[e + 4] = c2[e]; } }
        else {
#pragma unroll
            for (int e = 0; e < 8; ++e) { gm1[e] = 0.f; gm2[e] = 0.f; } }
        unpack8(e2, g0); unpack8(e3, g1); unpack8(q0, u0); unpack8(q1, u1);
#pragma unroll
        for (int e = 0; e < 8; ++e) {
            h0[e] = gelu_tanh(bb[e] + w0[e] * gm2[e] + w1[e] * gm1[e] + w2[e] * g0[e]) * u0[e];
            h1[e] = gelu_tanh(bb[e] + w0[e] * gm1[e] + w1[e] * g0[e] + w2[e] * g1[e]) * u1[e];
        }
        *(u32x4*)(H + (size_t)grp * 16 * 3072 + j0) = pack8(h0);
        *(u32x4*)(H + ((size_t)grp * 16 + 1) * 3072 + j0) = pack8(h1);
        if (smp || t0 == T - 16) {
            float* o = outp + (smp ? O_SF + (size_t)(layer * DB + b) * 2 * DFF : O_PF + (size_t)(layer * NB + b) * 2 * DFF) + j0;
            float s0[8], s1[8]; unpack8(e0, s0); unpack8(e1, s1);
            *(f32x4*)o = (f32x4){s0[0], s0[1], s0[2], s0[3]}; *(f32x4*)(o + 4) = (f32x4){s0[4], s0[5], s0[6], s0[7]};
            *(f32x4*)(o + DFF) = (f32x4){s1[0], s1[1], s1[2], s1[3]}; *(f32x4*)(o + DFF + 4) = (f32x4){s1[4], s1[5], s1[6], s1[7]};
        }
    }
}

DI void headnorm_phase(PP pp, int lane, int wave) {
    bf16_t* QKV = (bf16_t*)(pp->ws + WS_BIG);
    const float* kn = pp->in[19]; const float* qn = pp->in[22];
    const int gw = obid() * 8 + wave, NGW = ogrid() * 8;
    float* outp = pp->out;
    f32x4 kg[2][2], qg[2][2];
#pragma unroll
    for (int it = 0; it < 2; ++it) { const int d0 = ((it * 64 + lane) * 8) & 127;
        kg[it][0] = *(const f32x4*)(kn + d0); kg[it][1] = *(const f32x4*)(kn + d0 + 4); qg[it][0] = *(const f32x4*)(qn + d0) * QSCALE; qg[it][1] = *(const f32x4*)(qn + d0 + 4) * QSCALE; }
    for (int m2 = gw * 2; m2 < M; m2 += NGW * 2) {
        u32x4 kr[2][2], vr[2][2], qr[2][2];
#pragma unroll
        for (int r = 0; r < 2; ++r)
#pragma unroll
            for (int it = 0; it < 2; ++it) { const bf16_t* rp = QKV + (size_t)(m2 + r) * 3072 + (it * 64 + lane) * 8;
                kr[r][it] = *(const u32x4*)rp; vr[r][it] = *(const u32x4*)(rp + 1024); qr[r][it] = *(const u32x4*)(rp + 2048); }
#pragma unroll
        for (int r = 0; r < 2; ++r) {
            const int m = m2 + r;
            bf16_t* row = QKV + (size_t)m * 3072;
            float* ok = m < MP ? outp + O_PK + (size_t)m * D : outp + O_SK + (size_t)(m - MP) * D;
            float* ov = m < MP ? outp + O_PV + (size_t)m * D : outp + O_SV + (size_t)(m - MP) * D;
#pragma unroll
            for (int it = 0; it < 2; ++it) {
                const int col = (it * 64 + lane) * 8;
                float f[8]; float s;
                unpack8(kr[r][it], f); s = 0.f;
#pragma unroll
                for (int e = 0; e < 8; ++e) s += f[e] * f[e];
                s += __shfl_xor(s, 1); s += __shfl_xor(s, 2); s += __shfl_xor(s, 4); s += __shfl_xor(s, 8);
                float rs = __builtin_amdgcn_rsqf(s * (1.f / 128.f) + EPS);
#pragma unroll
                for (int e = 0; e < 4; ++e) { f[e] = f[e] * rs * kg[it][0][e]; f[e + 4] = f[e + 4] * rs * kg[it][1][e]; }
                *(f32x4*)(ok + col) = (f32x4){f[0], f[1], f[2], f[3]}; *(f32x4*)(ok + col + 4) = (f32x4){f[4], f[5], f[6], f[7]};
                *(u32x4*)(row + col) = pack8(f);
                unpack8(vr[r][it], f);
                *(f32x4*)(ov + col) = (f32x4){f[0], f[1], f[2], f[3]}; *(f32x4*)(ov + col + 4) = (f32x4){f[4], f[5], f[6], f[7]};
                unpack8(qr[r][it], f); s = 0.f;
#pragma unroll
                for (int e = 0; e < 8; ++e) s += f[e] * f[e];
                s += __shfl_xor(s, 1); s += __shfl_xor(s, 2); s += __shfl_xor(s, 4); s += __shfl_xor(s, 8);
                rs = __builtin_amdgcn_rsqf(s * (1.f / 128.f) + EPS);
#pragma unroll
                for (int e = 0; e < 4; ++e) { f[e] = f[e] * rs * qg[it][0][e]; f[e + 4] = f[e + 4] * rs * qg[it][1][e]; }
                *(u32x4*)(row + 2048 + col) = pack8(f);
            }
        }
    }
}

constexpr int AT_KP = 272, AT_VP = 136, AT_KB = 64 * AT_KP, AT_VB = 128 * AT_VP, AT_BUF = AT_KB + AT_VB, AT_FLAGS = 2 * AT_BUF;
template <bool SMP>
DI void attn_unit(PP pp, LAS unsigned char* lds, int tid, int lane, int wave, int b, int h, int qb) {
    const bf16_t* QKV = (const bf16_t*)(pp->ws + WS_BIG);
    bf16_t* AO = (bf16_t*)(pp->ws + WS_BIG + (size_t)M * 3072 * 2);
    const int mrow0 = SMP ? MP + b * DT : b * T;
    const int qpos0 = SMP ? PAST : qb * 256;
    const int qrow0 = SMP ? mrow0 : mrow0 + qb * 256;
    const int nq = SMP ? DT : 256;
    const int ntiles = SMP ? (PAST + DT - 2) / 64 + 1 : 4 * qb + 4;
    const int q = lane & 31, hl = lane >> 5, wq0 = 32 * wave;
    const bool wave_valid = wq0 < nq;
    const int myq = wq0 + q; const bool qvalid = myq < nq; const int qpos = qpos0 + myq; const int p_lo = qpos0 + wq0;
    LAS unsigned* sAlive = (LAS unsigned*)(lds + AT_FLAGS);
    bf16x8 qf[8];
    { const bf16_t* qp = QKV + (size_t)(qrow0 + (qvalid ? myq : 0)) * 3072 + 2048 + h * 128 + hl * 8;
#pragma unroll
      for (int s = 0; s < 8; ++s) qf[s] = *(const bf16x8*)(qp + s * 16); }
    f32x16 O[4];
#pragma unroll
    for (int dt = 0; dt < 4; ++dt)
#pragma unroll
        for (int j = 0; j < 16; ++j) O[dt][j] = 0.f;
    float R = 1.f; int wlive = 1;
    const float* ck = pp->in[5]; const float* cv = pp->in[6];
    u32x4 kr[2], vr[2];
#define AT_LOAD(kt_) do { if (!SMP) { _Pragma("unroll") for (int i = 0; i < 2; ++i) { const int c = tid + 512 * i, kl = c >> 4, part = c & 15, s = 64 * (kt_) + kl; \
        const bf16_t* rp = QKV + (size_t)(mrow0 + s) * 3072 + h * 128 + part * 8; kr[i] = *(const u32x4*)rp; vr[i] = *(const u32x4*)(rp + 1024); } } } while (0)
#define AT_STORE(buf_, kt_) do { LAS unsigned char* sK_ = lds + (buf_) * AT_BUF; LAS unsigned char* sV_ = sK_ + AT_KB; \
        _Pragma("unroll") for (int i = 0; i < 2; ++i) { const int c = tid + 512 * i, kl = c >> 4, part = c & 15; u32x4 kk, vv; \
            if (!SMP) { kk = kr[i]; vv = vr[i]; } \
            else { const int s = 64 * (kt_) + kl; \
                if (s < PAST) { const size_t off = (((size_t)b * PAST + s) * NH + h) * HD + part * 8; \
                    const f32x4 k0 = *(const f32x4*)(ck + off), k1 = *(const f32x4*)(ck + off + 4), v0 = *(const f32x4*)(cv + off), v1 = *(const f32x4*)(cv + off + 4); \
                    kk.x = pk2(k0[0], k0[1]); kk.y = pk2(k0[2], k0[3]); kk.z = pk2(k1[0], k1[1]); kk.w = pk2(k1[2], k1[3]); \
                    vv.x = pk2(v0[0], v0[1]); vv.y = pk2(v0[2], v0[3]); vv.z = pk2(v1[0], v1[1]); vv.w = pk2(v1[2], v1[3]); } \
                else if (s < PAST + DT) { const bf16_t* rp = QKV + (size_t)(mrow0 + s - PAST) * 3072 + h * 128 + part * 8; kk = *(const u32x4*)rp; vv = *(const u32x4*)(rp + 1024); } \
                else { kk = (u32x4){0u, 0u, 0u, 0u}; vv = kk; } } \
            *(LAS u32x4*)(sK_ + kl * AT_KP + part * 16) = kk; \
            LAS unsigned short* vp = (LAS unsigned short*)(sV_ + (part * 8) * AT_VP + kl * 2); \
            vp[0 * (AT_VP / 2)] = (unsigned short)(vv.x & 0xffffu); vp[1 * (AT_VP / 2)] = (unsigned short)(vv.x >> 16); \
            vp[2 * (AT_VP / 2)] = (unsigned short)(vv.y & 0xffffu); vp[3 * (AT_VP / 2)] = (unsigned short)(vv.y >> 16); \
            vp[4 * (AT_VP / 2)] = (unsigned short)(vv.z & 0xffffu); vp[5 * (AT_VP / 2)] = (unsigned short)(vv.z >> 16); \
            vp[6 * (AT_VP / 2)] = (unsigned short)(vv.w & 0xffffu); vp[7 * (AT_VP / 2)] = (unsigned short)(vv.w >> 16); } } while (0)

    AT_LOAD(ntiles - 1); AT_STORE(0, ntiles - 1);
    __syncthreads();
    int it = 0;
    for (int kt = ntiles - 1; kt >= 0; --kt, ++it) {
        if (kt > 0) AT_LOAD(kt - 1);
        const LAS unsigned char* sK = lds + (it & 1) * AT_BUF; const LAS unsigned char* sVt = sK + AT_KB;
        if (wave_valid && wlive) {
#pragma unroll
            for (int sub = 1; sub >= 0; --sub) {
                const int kbase = 64 * kt + 32 * sub;
                if (kbase <= p_lo + 30) {
                    f32x16 S;
#pragma unroll
                    for (int j = 0; j < 16; ++j) S[j] = 0.f;
#pragma unroll
                    for (int s = 0; s < 8; ++s) { const bf16x8 kf = *(const LAS bf16x8*)(sK + (32 * sub + q) * AT_KP + s * 32 + hl * 16); S = MFMA32(kf, qf[s], S); }
                    float sg[16];
                    if (kbase + 31 >= p_lo) {
#pragma unroll
                        for (int j = 0; j < 16; ++j) {
                            const int key = kbase + 8 * (j >> 2) + 4 * hl + (j & 3);
                            const float v = frcp(1.0f + fexp2(S[j]));
                            sg[j] = key >= qpos ? 1.0f : v;
                        }
                    } else {
#pragma unroll
                        for (int j = 0; j < 16; ++j) sg[j] = frcp(1.0f + fexp2(S[j]));
                    }
                    float Gq[4], pr[4], Tg[4];
#pragma unroll
                    for (int g = 0; g < 4; ++g) { const float gp = (sg[4 * g] * sg[4 * g + 1]) * (sg[4 * g + 2] * sg[4 * g + 3]); Gq[g] = __shfl_xor(gp, 32); pr[g] = gp * Gq[g]; }
                    Tg[3] = 1.f; Tg[2] = pr[3]; Tg[1] = pr[3] * pr[2]; Tg[0] = Tg[1] * pr[1];
                    float w[16];
#pragma unroll
                    for (int g = 0; g < 4; ++g) {
                        float P = R * Tg[g]; if (hl == 0) P *= Gq[g];
                        w[4 * g + 3] = (1.0f - sg[4 * g + 3]) * P; P *= sg[4 * g + 3];
                        w[4 * g + 2] = (1.0f - sg[4 * g + 2]) * P; P *= sg[4 * g + 2];
                        w[4 * g + 1] = (1.0f - sg[4 * g + 1]) * P; P *= sg[4 * g + 1];
                        w[4 * g] = (1.0f - sg[4 * g]) * P;
                    }
                    R = R * Tg[0] * pr[0];
#pragma unroll
                    for (int ks = 0; ks < 2; ++ks) {
                        u32x4 wp; wp.x = pk2(w[8 * ks], w[8 * ks + 1]); wp.y = pk2(w[8 * ks + 2], w[8 * ks + 3]); wp.z = pk2(w[8 * ks + 4], w[8 * ks + 5]); wp.w = pk2(w[8 * ks + 6], w[8 * ks + 7]);
                        const bf16x8 wf = __builtin_bit_cast(bf16x8, wp);
#pragma unroll
                        for (int dt = 0; dt < 4; ++dt) {
                            const LAS unsigned char* vp = sVt + (32 * dt + q) * AT_VP + (32 * sub + 16 * ks + 4 * hl) * 2;
                            const u32x2 v0 = *(const LAS u32x2*)vp, v1 = *(const LAS u32x2*)(vp + 16);
                            const u32x4 vv = {v0.x, v0.y, v1.x, v1.y};
                            O[dt] = MFMA32(__builtin_bit_cast(bf16x8, vv), wf, O[dt]);
                        }
                    }
                }
            }
        }
        {
            const bool started = wave_valid && (64 * kt <= p_lo + 30);
            const unsigned long long bal = __ballot(qvalid && R != 0.f);
            const unsigned alive = wave_valid ? ((!started || bal != 0ull) ? 1u : 0u) : 0u;
            wlive = __builtin_amdgcn_readfirstlane((int)alive);
            if (lane == 0) sAlive[(it & 1) * 8 + wave] = alive;
        }
        if (kt > 0) AT_STORE((it + 1) & 1, kt - 1);
        __syncthreads();
        unsigned any = 0;
#pragma unroll
        for (int w8 = 0; w8 < 8; ++w8) any |= sAlive[(it & 1) * 8 + w8];
        if (!any) break;
    }
#undef AT_LOAD
#undef AT_STORE
    if (wave_valid && qvalid) {
        bf16_t* orow = AO + (size_t)(qrow0 + myq) * 1024 + h * 128 + 4 * hl;
#pragma unroll
        for (int dt = 0; dt < 4; ++dt)
#pragma unroll
            for (int g = 0; g < 4; ++g) { u32x2 w; w.x = pk2(O[dt][4 * g], O[dt][4 * g + 1]); w.y = pk2(O[dt][4 * g + 2], O[dt][4 * g + 3]); *(u32x2*)(orow + 32 * dt + 8 * g) = w; }
    }
}
DI void attn_phase(PP pp, LAS unsigned char* lds, int tid, int lane, int wave) {
    for (int u = obid(); u < 128 + 2048; u += ogrid()) {
        if (u < 128) attn_unit<true>(pp, lds, tid, lane, wave, u >> 3, u & 7, 0);
        else { const int v = u - 128, qb = 7 - (v >> 8), rem = v & 255; attn_unit<false>(pp, lds, tid, lane, wave, rem >> 3, rem & 7, qb); }
        __syncthreads();
    }
}

DI void final_phase(PP pp, int lane, int wave) {
    const int gw = obid() * 8 + wave, NGW = ogrid() * 8; const float* gn = pp->in[29];
    const bf16_t* XB = (const bf16_t*)(pp->ws + WS_XB);
    f32x4 gv[4];
#pragma unroll
    for (int j = 0; j < 4; ++j) gv[j] = *((const f32x4*)gn + lane + 64 * j);
    float* outp = pp->out;
    for (int m4 = gw * 4; m4 < M; m4 += NGW * 4) {
        u32x2 raw[4][4];
#pragma unroll
        for (int r = 0; r < 4; ++r)
#pragma unroll
            for (int j = 0; j < 4; ++j) raw[r][j] = __builtin_nontemporal_load((const u32x2*)(XB + (size_t)(m4 + r) * D) + lane + 64 * j);
#pragma unroll
        for (int r = 0; r < 4; ++r) {
            f32x4 v[4]; float s = 0.f;
#pragma unroll
            for (int j = 0; j < 4; ++j) { v[j] = (f32x4){bflo(raw[r][j].x), bfhi(raw[r][j].x), bflo(raw[r][j].y), bfhi(raw[r][j].y)};
                s += (v[j][0] * v[j][0] + v[j][1] * v[j][1]) + (v[j][2] * v[j][2] + v[j][3] * v[j][3]); }
            const float rstd = __builtin_amdgcn_rsqf(wave_sum(s) * (1.f / D) + EPS);
#pragma unroll
            for (int j = 0; j < 4; ++j) *((f32x4*)(outp + (size_t)(m4 + r) * D) + lane + 64 * j) = v[j] * rstd * gv[j];
        }
    }
}

#define XB_TMO      128
#define XB_XCNT(j)  (256  + 64 * (j))
#define XB_XSUB(j)  (1280 + 64 * (j))
#define XB_XGEN(j)  (2304 + 64 * (j))
#define XB_TOP      3328
#define XB_TOPGEN   3392
#define XCD_BAR_WORDS 3456
#define XB_SPIN_CAP (1u << 18)

__device__ __forceinline__ unsigned xb_ld(unsigned* p)              { return __hip_atomic_load(p, __ATOMIC_RELAXED, __HIP_MEMORY_SCOPE_AGENT); }
__device__ __forceinline__ unsigned xb_add(unsigned* p, unsigned v) { return __hip_atomic_fetch_add(p, v, __ATOMIC_RELAXED, __HIP_MEMORY_SCOPE_AGENT); }
__device__ __forceinline__ unsigned xb_xcc_id() { return (unsigned)__builtin_amdgcn_s_getreg((3 << 11) | 20) & 0xFu; }
#define XB_SPIN(cond, bar) do { unsigned _sp = 0; while (cond) { __builtin_amdgcn_s_sleep(1); \
    if ((++_sp & 255u) == 0u) { if (xb_ld(&(bar)[XB_TMO])) break; if (_sp > XB_SPIN_CAP) { atomicAdd(&(bar)[XB_TMO], 1u); break; } } } } while (0)

struct XcdBarrier {
    unsigned* bar; unsigned x;
    volatile LAS unsigned* st;
};

__device__ __forceinline__ XcdBarrier xcd_barrier_post(unsigned* bar, volatile LAS unsigned* st) {
    XcdBarrier b; b.bar = bar; b.x = xb_xcc_id(); b.st = st;
    if (threadIdx.x == 0) (void)xb_add(&bar[XB_XCNT(b.x)], 1u);
    return b;
}
__device__ __forceinline__ void xcd_barrier_complete(unsigned* bar, unsigned x, unsigned& nloc, unsigned& nx) {
    const unsigned G = gridDim.x * gridDim.y * gridDim.z;
    unsigned sum, cnt, mine, sp = 0u;
    for (;;) {
        sum = 0u; cnt = 0u; mine = 0u;
#pragma unroll
        for (unsigned j = 0; j < 16; ++j) { const unsigned c = xb_ld(&bar[XB_XCNT(j)]); sum += c; cnt += (c > 0u) ? 1u : 0u; mine = (j == x) ? c : mine; }
        if (sum == G) break;
        __builtin_amdgcn_s_sleep(1);
        if ((++sp & 255u) == 0u) { if (xb_ld(&bar[XB_TMO])) break; if (sp > XB_SPIN_CAP) { atomicAdd(&bar[XB_TMO], 1u); break; } }
    }
    nloc = mine > 0u ? mine : 1u; nx = cnt > 0u ? cnt : 1u;
}

__device__ __forceinline__ void xcd_barrier(const XcdBarrier& b) {
    asm volatile("s_waitcnt vmcnt(0)" ::: "memory");
    __syncthreads();
    if (threadIdx.x == 0) {
        unsigned* bar = b.bar;
        __builtin_amdgcn_s_waitcnt(0);
        unsigned nloc = b.st[0], nx = b.st[1];
        if (nloc == 0u) { xcd_barrier_complete(bar, b.x, nloc, nx); b.st[0] = nloc; b.st[1] = nx; }
        const unsigned old = xb_add(&bar[XB_XSUB(b.x)], 1u);
        const unsigned gen = old / nloc;
        if (old + 1u == (gen + 1u) * nloc) {
            __builtin_amdgcn_fence(__ATOMIC_RELEASE, "agent");
            asm volatile("s_waitcnt vmcnt(0)" ::: "memory");
            const unsigned og = xb_add(&bar[XB_TOP], 1u);
            const unsigned tg = og / nx;
            if (og + 1u == (tg + 1u) * nx) xb_add(&bar[XB_TOPGEN], 1u);
            else XB_SPIN(xb_ld(&bar[XB_TOPGEN]) == tg, bar);
            __builtin_amdgcn_fence(__ATOMIC_ACQUIRE, "agent");
            xb_add(&bar[XB_XGEN(b.x)], 1u);
            asm volatile("s_waitcnt vmcnt(0)" ::: "memory");
        } else {
            XB_SPIN(xb_ld(&bar[XB_XGEN(b.x)]) == gen, bar);
            __builtin_amdgcn_fence(__ATOMIC_ACQUIRE, "agent");
            asm volatile("s_waitcnt vmcnt(0)" ::: "memory");
        }
    }
    __syncthreads();
}

__global__ void __launch_bounds__(512, 2) fwd_kernel(Params p) {
    extern __shared__ __attribute__((aligned(16))) unsigned char lds_raw[];
    LAS unsigned char* lds = (LAS unsigned char*)lds_raw;
    cg::grid_group grid = cg::this_grid();
    constexpr int LDS_ST = 143360;
    { const int t0_ = otid(); if (t0_ < 2) ((LAS unsigned*)(lds + LDS_ST))[t0_] = 0u; __syncthreads();
      PP pp0 = (PP)__builtin_amdgcn_kernarg_segment_ptr(); (void)xcd_barrier_post((unsigned*)(pp0->ws + WS_CW), (volatile LAS unsigned*)(lds + LDS_ST)); }
#pragma unroll 1
    for (int ph = 0; ph < 15; ++ph) {
        if (ph == 8) continue;
        const int tid = otid(), lane = tid & 63, wave = __builtin_amdgcn_readfirstlane(tid >> 6), bid = obid(), nblk = ogrid();
        PP pp = (PP)__builtin_amdgcn_kernarg_segment_ptr();
        asm volatile("" : "+s"(pp));
        unsigned char* ws = pp->ws;
        bf16_t* XB = (bf16_t*)(ws + WS_XB); float* SS = (float*)(ws + WS_SS); bf16_t* BIG = (bf16_t*)(ws + WS_BIG);
        float* X = pp->out;
        if (ph == 4 || ph == 11) {
            const int layer = ph == 4 ? 0 : 1;
            const bf16_t* Bt = (const bf16_t*)(ws + (layer ? WS_WUP1 : WS_WUP0));
            pg8::Gemm g{XB, Bt, M, 6144, 1024, 1024}; pg8::StaticOrder S; S.init(M, 6144, nblk, bid);
            bf16_t* EGp = BIG + (size_t)M * 3072;
            pg8::EpiFfn E{BIG, EGp, EGp + (size_t)(M / 16) * 4 * 3072, SS, pp->in[26] + (size_t)layer * 3 * DFF, pp->in[27] + (size_t)layer * DFF};
            pg8::gemm_phase<pg8::EpiFfn, pg8::StaticOrder, true, true>(lds, g, S, E);
        } else if (ph == 7) {
            pg8::Gemm g{XB, (const bf16_t*)(ws + WS_WQKV), M, 3072, 1024, 1024}; pg8::StaticOrder S; S.init(M, 3072, nblk, bid);
            pg8::EpiQkv E{BIG, X, SS, pp->in[19], pp->in[22], (LAS float*)(lds + 131072), O_PK, O_PV, O_SK, O_SV, MP, QSCALE};
            pg8::gemm_phase<pg8::EpiQkv, pg8::StaticOrder, true, true>(lds, g, S, E);
        } else if (ph == 1) {
            const bf16_t* Bt; int N; const float* ss = SS;
            { Bt = (const bf16_t*)(ws + WS_WIN); N = 2048; }
            pg8::Gemm g{XB, Bt, M, N, 1024, 1024}; pg8::StaticOrder S; S.init(M, N, nblk, bid);
            pg8::EpiScaleBf16 E{BIG, N, ss};
#if !defined(NO_GS)
            pg8::gemm_phase<pg8::EpiScaleBf16, pg8::StaticOrder, true, true>(lds, g, S, E);
#endif
#if defined(PROBE_GS2)
            grid.sync(); pg8::gemm_phase<pg8::EpiScaleBf16, pg8::StaticOrder, true, true>(lds, g, S, E);
#endif
        } else if (ph == 3 || ph == 6 || ph == 10 || ph == 13) {
            const bf16_t* A; const bf16_t* Bt; int K, lda;
            if (ph == 3) { A = BIG + (size_t)M * 2048; lda = 1024; K = 1024; Bt = (const bf16_t*)(ws + WS_WOUT); }
            else if (ph == 6) { A = BIG; lda = 3072; K = 3072; Bt = (const bf16_t*)(ws + WS_WDN0); }
            else if (ph == 10) { A = BIG + (size_t)M * 3072; lda = 1024; K = 1024; Bt = (const bf16_t*)(ws + WS_WO); }
            else { A = BIG; lda = 3072; K = 3072; Bt = (const bf16_t*)(ws + WS_WDN1); }
            pg8::Gemm g{A, Bt, M, 1024, K, lda}; pg8::StaticOrder S; S.init(M, 1024, nblk, bid);
            pg8::EpiResid E{XB, SS};
#if !defined(NO_GR)
            pg8::gemm_phase<pg8::EpiResid, pg8::StaticOrder, true, true>(lds, g, S, E);
#endif
        }
#if !defined(NO_P0)
        else if (ph == 0) phase0(pp, lds, lane, wave);
#endif
#if !defined(NO_LRU)
        else if (ph == 2) {
#if defined(PROBE_L2)
            _Pragma("unroll 1") for (int rep = 0; rep < 2; ++rep) { if (rep) grid.sync(); lru_phase(pp, lds, tid, lane, wave); }
#else
            lru_phase(pp, lds, tid, lane, wave);
#endif
        }
#endif
#if !defined(NO_ACT)
        else if (ph == 5 || ph == 12) ffn_fix_phase(pp, ph == 5 ? 0 : 1, tid);
#endif
#if !defined(NO_HN)
        else if (ph == 8) headnorm_phase(pp, lane, wave);
#endif
#if !defined(NO_ATT)
        else if (ph == 9) {
#if defined(PROBE_A2)
            _Pragma("unroll 1") for (int rep = 0; rep < 2; ++rep) { if (rep) grid.sync(); attn_phase(pp, lds, tid, lane, wave); }
#else
            attn_phase(pp, lds, tid, lane, wave);
#endif
        }
#endif
#if !defined(NO_FIN)
        else if (ph == 14) final_phase(pp, lane, wave);
#endif
        if (ph == 0) grid.sync();
        else if (ph < 14) { XcdBarrier xb; xb.bar = (unsigned*)(ws + WS_CW); xb.x = xb_xcc_id(); xb.st = (volatile LAS unsigned*)(lds + LDS_ST); xcd_barrier(xb); }
    }
}

extern "C" void kernel_launch(void* const* d_in, const int* in_sizes, int n_in, void* d_out, int out_size, void* d_ws, size_t ws_size, hipStream_t stream) {
    static int grid = 0;
    if (grid == 0) {
        if (n_in != 30 || (size_t)out_size != O_END || ws_size < WS_END) { fprintf(stderr, "kernel_launch: unexpected shapes n_in %d out %d ws %zu (need %zu)\n", n_in, out_size, ws_size, (size_t)WS_END); grid = -1; return; }
        int dev = 0, cus = 0, per_cu = 0;
        hipGetDevice(&dev); hipDeviceGetAttribute(&cus, hipDeviceAttributeMultiprocessorCount, dev);
        if (hipFuncSetAttribute((const void*)fwd_kernel, hipFuncAttributeMaxDynamicSharedMemorySize, LDS_BYTES) != hipSuccess) { fprintf(stderr, "kernel_launch: hipFuncSetAttribute failed\n"); grid = -1; return; }
        if (hipOccupancyMaxActiveBlocksPerMultiprocessor(&per_cu, (const void*)fwd_kernel, 512, LDS_BYTES) != hipSuccess || per_cu < 1) { fprintf(stderr, "kernel_launch: occupancy query failed (%d)\n", per_cu); per_cu = 1; }
        (void)hipGetLastError();
        grid = cus * per_cu;
    }
    if (grid < 0) return;
    if (hipMemsetAsync((char*)d_ws + WS_CW, 0, CW_BYTES, stream) != hipSuccess) { fprintf(stderr, "kernel_launch: memset of the barrier words failed\n"); return; }
    Params p{};
    for (int i = 0; i < 30; ++i) p.in[i] = (const float*)d_in[i];
    p.out = (float*)d_out; p.ws = (unsigned char*)d_ws;
    void* args[] = {&p};
    hipError_t e = hipLaunchCooperativeKernel((const void*)fwd_kernel, dim3(grid), dim3(512), args, LDS_BYTES, stream);
    if (e != hipSuccess) fprintf(stderr, "cooperative launch failed: %s (grid %d)\n", hipGetErrorString(e), grid);
}
```

```cpp
#include <hip/hip_runtime.h>
#include <hip/hip_cooperative_groups.h>
#include <cstdio>
#include <cstdint>
namespace cg = cooperative_groups;

#define DI __device__ __forceinline__
#define LAS __attribute__((address_space(3)))

constexpr int D = 1024, NB = 32, T = 2048, DB = 16, DT = 16, PAST = 4096, NH = 8, HD = 128, DFF = 3072, NBLK = 16, BLK = 64;
constexpr int MP = NB * T, MS = DB * DT, M = MP + MS;
constexpr float EPS = 1e-6f;
constexpr float LOG2E = 1.4426950408889634f;
constexpr float QSCALE = 0.08838834764831845f * LOG2E;

constexpr size_t O_YP = 0, O_YS = O_YP + (size_t)MP * D, O_PH = O_YS + (size_t)MS * D, O_PC = O_PH + (size_t)NB * D, O_PF = O_PC + (size_t)NB * 3 * D,
                 O_PK = O_PF + (size_t)2 * NB * 2 * DFF, O_PV = O_PK + (size_t)MP * D, O_SH = O_PV + (size_t)MP * D, O_SC = O_SH + (size_t)DB * D,
                 O_SF = O_SC + (size_t)DB * 3 * D, O_SK = O_SF + (size_t)2 * DB * 2 * DFF, O_SV = O_SK + (size_t)MS * D, O_END = O_SV + (size_t)MS * D;
static_assert(O_END == 202899456ull, "output size");

constexpr size_t MiB = 1u << 20;
constexpr size_t WS_WIN = 0, WS_WOUT = 4 * MiB, WS_WUP0 = 6 * MiB, WS_WUP1 = 18 * MiB, WS_WDN0 = 30 * MiB, WS_WDN1 = 36 * MiB, WS_WQKV = 42 * MiB, WS_WO = 48 * MiB,
                 WS_WRT = 50 * MiB, WS_WIT = 50 * MiB + 128 * 1024, WS_SS = 52 * MiB, WS_CW = 57 * MiB  , CW_BYTES = 16 * 1024, WS_XB = 58 * MiB, WS_BIG = 187 * MiB, WS_END = WS_BIG + (size_t)M * 6144 * 2;
static_assert(WS_XB + (size_t)M * D * 2 <= WS_BIG && WS_SS + (size_t)M * 16 * 4 <= WS_XB && WS_END <= 1024 * MiB, "ws map");

constexpr int LDS_BYTES = 147456;

typedef unsigned short bf16_t;
typedef float f32x2 __attribute__((ext_vector_type(2)));
typedef float f32x4 __attribute__((ext_vector_type(4)));
typedef float f32x16 __attribute__((ext_vector_type(16)));
typedef short bf16x8 __attribute__((ext_vector_type(8)));
typedef short s16x4 __attribute__((ext_vector_type(4)));
typedef unsigned u32x4 __attribute__((ext_vector_type(4)));
typedef unsigned u32x2 __attribute__((ext_vector_type(2)));
typedef __bf16 bf16x2_t __attribute__((ext_vector_type(2)));

DI unsigned pk2(float lo, float hi) { f32x2 v = {lo, hi}; bf16x2_t b = __builtin_convertvector(v, bf16x2_t); return __builtin_bit_cast(unsigned, b); }
DI float bflo(unsigned u) { return __uint_as_float(u << 16); }
DI float bfhi(unsigned u) { return __uint_as_float(u & 0xffff0000u); }
DI void unpack8(const u32x4 v, float (&f)[8]) { f[0] = bflo(v.x); f[1] = bfhi(v.x); f[2] = bflo(v.y); f[3] = bfhi(v.y); f[4] = bflo(v.z); f[5] = bfhi(v.z); f[6] = bflo(v.w); f[7] = bfhi(v.w); }
DI u32x4 pack8(const float (&f)[8]) { u32x4 w; w.x = pk2(f[0], f[1]); w.y = pk2(f[2], f[3]); w.z = pk2(f[4], f[5]); w.w = pk2(f[6], f[7]); return w; }
DI float fexp2(float x) { return __builtin_amdgcn_exp2f(x); }
DI float frcp(float x) { return __builtin_amdgcn_rcpf(x); }
DI float sigmoidf_(float x) { return frcp(1.0f + fexp2(-x * LOG2E)); }
DI float gelu_tanh(float x) { const float u = 0.7978845608028654f * (x + 0.044715f * x * x * x); return x * frcp(1.0f + fexp2(-2.0f * LOG2E * u)); }
DI float wave_sum(float v) {
#pragma unroll
    for (int o = 1; o < 64; o <<= 1) v += __shfl_xor(v, o);
    return v;
}
namespace pg8 {
#define PG8_LAS __attribute__((address_space(3)))
typedef unsigned short bf16_t;
typedef short bf16x8 __attribute__((ext_vector_type(8)));
typedef float f32x4 __attribute__((ext_vector_type(4)));
typedef unsigned u32x4 __attribute__((ext_vector_type(4)));
constexpr int BM = 256, BK = 64, HALF = 128, HTB = HALF * BK * 2  , STAGE_BYTES = 8 * HTB, NXCD = 8, WGM = 8;

__host__ __device__ __forceinline__ int lds_byte(int r, int c) { const int st = (r >> 4) * 2 + (c >> 5), rr = r & 15, cc = c & 31, ob = rr * 64 + cc * 2; return st * 1024 + (ob ^ (((ob >> 9) & 1) << 5)); }
__host__ __device__ __forceinline__ void stage_rc(int b, int& R, int& C) { const int st = b / 1024, sb = b % 1024, swz = sb ^ (((sb >> 9) & 1) << 5); R = (st >> 1) * 16 + swz / 64; C = (st & 1) * 32 + (swz % 64) / 2; }
__host__ __device__ __forceinline__ int perm32(int rho) { const int n = rho >> 4, i = rho & 15; return 8 * (i >> 2) + 4 * n + (i & 3); }

struct Unit { int pm, pn; };
struct Gemm { const bf16_t* A; const bf16_t* Bt; int M, N, K, lda; };

struct StaticOrder {
    int nM, nN, nwg, G, c;
    __host__ __device__ void init(int M, int N, int G_, int c_) { nM = M / BM; nN = N / BM; nwg = nM * nN; G = G_; c = c_; }
    __host__ __device__ bool next(int i, Unit& u) const {
        const long L = (long)i * G + c; if (L >= nwg) return false;
        int wgid = (int)L; { const int q = nwg / NXCD, r = nwg % NXCD, xcd = wgid % NXCD, off = wgid / NXCD; wgid = (xcd < r ? xcd * (q + 1) : r * (q + 1) + (xcd - r) * q) + off; }
        const int nig = WGM * nN, gid = wgid / nig, fm = gid * WGM, gsz = (nM - fm) < WGM ? (nM - fm) : WGM;
        u.pm = fm + ((wgid % nig) % gsz); u.pn = (wgid % nig) / gsz; return true;
    }
    __device__ __forceinline__ void a_ready(const Unit&) const {}
    __device__ __forceinline__ void done(const Unit&) const {}
};
__device__ __forceinline__ unsigned cvt_pk_bf16(float lo, float hi) { unsigned r; asm volatile("v_cvt_pk_bf16_f32 %0, %1, %2" : "=v"(r) : "v"(lo), "v"(hi)); return r; }
DI float row_rstd(const float* ss, int row) {
    const f32x4* p = (const f32x4*)(ss + (size_t)row * 16);
    const f32x4 a = p[0], b = p[1], c = p[2], d = p[3];
    const float s = ((a[0] + a[1]) + (a[2] + a[3])) + ((b[0] + b[1]) + (b[2] + b[3])) + ((c[0] + c[1]) + (c[2] + c[3])) + ((d[0] + d[1]) + (d[2] + d[3]));
    return __builtin_amdgcn_rsqf(s * (1.0f / 1024.0f) + 1e-6f);
}
struct EpiScaleBf16 {
    static constexpr bool PERM = true, AFTER_DRAIN = false;
    bf16_t* O; int ldc; const float* ss;
    DI void operator()(const f32x4 (&acc)[2][2][4][2], const Unit& u, int wr, int wc, int fr, int fq) const {
        const int row0 = u.pm * BM + wr * 64 + fr, col0 = u.pn * BM + wc * 32 + 8 * fq;
#pragma unroll
        for (int ai = 0; ai < 2; ++ai)
#pragma unroll
            for (int m = 0; m < 4; ++m) {
                const int row = row0 + ai * HALF + m * 16;
                const float sc = ss ? row_rstd(ss, row) : 1.0f;
                bf16_t* rowp = O + (size_t)row * ldc + col0;
#pragma unroll
                for (int bj = 0; bj < 2; ++bj) {
                    const f32x4 v0 = acc[ai][bj][m][0] * sc, v1 = acc[ai][bj][m][1] * sc;
                    u32x4 w; w.x = cvt_pk_bf16(v0[0], v0[1]); w.y = cvt_pk_bf16(v0[2], v0[3]); w.z = cvt_pk_bf16(v1[0], v1[1]); w.w = cvt_pk_bf16(v1[2], v1[3]);
                    *(u32x4*)(rowp + bj * HALF) = w;
                }
                if (m & 1) asm volatile("" ::: "memory");
            }
    }
};
struct EpiResid {
    static constexpr bool PERM = true, AFTER_DRAIN = false;
    bf16_t* XB; float* ss;
    DI void operator()(const f32x4 (&acc)[2][2][4][2], const Unit& u, int wr, int wc, int fr, int fq) const {
        const int row0 = u.pm * BM + wr * 64 + fr, col0 = u.pn * BM + wc * 32 + 8 * fq;
#pragma unroll
        for (int ai = 0; ai < 2; ++ai)
#pragma unroll
            for (int m = 0; m < 4; ++m) {
                const int row = row0 + ai * HALF + m * 16;
                bf16_t* xb = XB + (size_t)row * 1024 + col0;
                float sq = 0.f;
#pragma unroll
                for (int bj = 0; bj < 2; ++bj) {
                    const u32x4 r = *(const u32x4*)(xb + bj * HALF);
                    const f32x4 r0 = {__uint_as_float(r.x << 16), __uint_as_float(r.x & 0xffff0000u), __uint_as_float(r.y << 16), __uint_as_float(r.y & 0xffff0000u)};
                    const f32x4 r1 = {__uint_as_float(r.z << 16), __uint_as_float(r.z & 0xffff0000u), __uint_as_float(r.w << 16), __uint_as_float(r.w & 0xffff0000u)};
                    const f32x4 v0 = acc[ai][bj][m][0] + r0, v1 = acc[ai][bj][m][1] + r1;
                    u32x4 w; w.x = cvt_pk_bf16(v0[0], v0[1]); w.y = cvt_pk_bf16(v0[2], v0[3]); w.z = cvt_pk_bf16(v1[0], v1[1]); w.w = cvt_pk_bf16(v1[2], v1[3]);
                    *(u32x4*)(xb + bj * HALF) = w;
                    sq += (v0[0] * v0[0] + v0[1] * v0[1]) + (v0[2] * v0[2] + v0[3] * v0[3]) + (v1[0] * v1[0] + v1[1] * v1[1]) + (v1[2] * v1[2] + v1[3] * v1[3]);
                }
                sq += __shfl_xor(sq, 16); sq += __shfl_xor(sq, 32);
                if (fq == 0) ss[(size_t)row * 16 + u.pn * 4 + wc] = sq;
                if (m & 1) asm volatile("" ::: "memory");
            }
    }
};
struct EpiFfn {
    static constexpr bool PERM = true, AFTER_DRAIN = false;
    bf16_t* H; bf16_t* EG; bf16_t* EU; const float* ss; const float* cw; const float* cb;
    DI void operator()(const f32x4 (&acc)[2][2][4][2], const Unit& u, int wr, int wc, int fr, int fq) const {
        const int row0 = u.pm * BM + wr * 64 + fr, hc = u.pn * HALF + wc * 32 + 8 * fq;
        float w0[8], w1[8], w2[8], bb[8];
        { const f32x4 a0 = *(const f32x4*)(cw + hc), a1 = *(const f32x4*)(cw + hc + 4), b0 = *(const f32x4*)(cw + 3072 + hc), b1 = *(const f32x4*)(cw + 3072 + hc + 4),
                      c0 = *(const f32x4*)(cw + 6144 + hc), c1 = *(const f32x4*)(cw + 6144 + hc + 4), d0 = *(const f32x4*)(cb + hc), d1 = *(const f32x4*)(cb + hc + 4);
#pragma unroll
          for (int i = 0; i < 4; ++i) { w0[i] = a0[i]; w0[i + 4] = a1[i]; w1[i] = b0[i]; w1[i + 4] = b1[i]; w2[i] = c0[i]; w2[i + 4] = c1[i]; bb[i] = d0[i]; bb[i + 4] = d1[i]; } }
#pragma unroll
        for (int ai = 0; ai < 2; ++ai)
#pragma unroll
            for (int m = 0; m < 4; ++m) {
                const int row = row0 + ai * HALF + m * 16;
                const float sc = row_rstd(ss, row);
                float g[8], uu[8];
#pragma unroll
                for (int i = 0; i < 4; ++i) { g[i] = acc[ai][0][m][0][i] * sc; g[i + 4] = acc[ai][0][m][1][i] * sc; uu[i] = acc[ai][1][m][0][i] * sc; uu[i + 4] = acc[ai][1][m][1][i] * sc; }
                u32x4 hw; unsigned hp[4];
#pragma unroll
                for (int i = 0; i < 8; i += 2) {
                    const float pa1 = __shfl_up(g[i], 1, 16), pa2 = __shfl_up(g[i], 2, 16), pb1 = __shfl_up(g[i + 1], 1, 16), pb2 = __shfl_up(g[i + 1], 2, 16);
                    const float ca = bb[i] + w0[i] * pa2 + w1[i] * pa1 + w2[i] * g[i], cb2 = bb[i + 1] + w0[i + 1] * pb2 + w1[i + 1] * pb1 + w2[i + 1] * g[i + 1];
                    const float ua = 0.7978845608028654f * (ca + 0.044715f * ca * ca * ca), ub = 0.7978845608028654f * (cb2 + 0.044715f * cb2 * cb2 * cb2);
                    const float ha = ca * __builtin_amdgcn_rcpf(1.0f + __builtin_amdgcn_exp2f(-2.8853900817779268f * ua)) * uu[i];
                    const float hb = cb2 * __builtin_amdgcn_rcpf(1.0f + __builtin_amdgcn_exp2f(-2.8853900817779268f * ub)) * uu[i + 1];
                    hp[i >> 1] = cvt_pk_bf16(ha, hb);
                }
                hw.x = hp[0]; hw.y = hp[1]; hw.z = hp[2]; hw.w = hp[3];
                if (fr >= 2) *(u32x4*)(H + (size_t)row * 3072 + hc) = hw;
                if (fr >= 14 || fr < 2) {
                    u32x4 gw; gw.x = cvt_pk_bf16(g[0], g[1]); gw.y = cvt_pk_bf16(g[2], g[3]); gw.z = cvt_pk_bf16(g[4], g[5]); gw.w = cvt_pk_bf16(g[6], g[7]);
                    *(u32x4*)(EG + ((size_t)(row >> 4) * 4 + ((fr + 2) & 3)) * 3072 + hc) = gw;
                    if (fr < 2) { u32x4 uw; uw.x = cvt_pk_bf16(uu[0], uu[1]); uw.y = cvt_pk_bf16(uu[2], uu[3]); uw.z = cvt_pk_bf16(uu[4], uu[5]); uw.w = cvt_pk_bf16(uu[6], uu[7]);
                        *(u32x4*)(EU + ((size_t)(row >> 4) * 2 + fr) * 3072 + hc) = uw; }
                }
                asm volatile("" ::: "memory");
            }
    }
};

struct EpiQkv {
    static constexpr bool PERM = true, AFTER_DRAIN = false;
    bf16_t* O; float* outp; const float* ss; const float* kn; const float* qn; PG8_LAS float* part;
    size_t o_pk, o_pv, o_sk, o_sv; int mp; float qscale;
    DI void operator()(const f32x4 (&acc)[2][2][4][2], const Unit& u, int wr, int wc, int fr, int fq) const {
        const int kind = u.pn >> 2;
        const int row0 = u.pm * BM + wr * 64 + fr, col0 = u.pn * BM + wc * 32 + 8 * fq, hcol = (u.pn & 3) * BM + wc * 32 + 8 * fq;
        if (kind == 1) {
#pragma unroll
            for (int ai = 0; ai < 2; ++ai)
#pragma unroll
                for (int m = 0; m < 4; ++m) {
                    const int row = row0 + ai * HALF + m * 16;
                    const float sc = row_rstd(ss, row);
                    const size_t ob = (row < mp ? o_pv + (size_t)row * 1024 : o_sv + (size_t)(row - mp) * 1024) + hcol;
#pragma unroll
                    for (int bj = 0; bj < 2; ++bj) {
                        const f32x4 v0 = acc[ai][bj][m][0] * sc, v1 = acc[ai][bj][m][1] * sc;
                        *(f32x4*)(outp + ob + bj * HALF) = v0; *(f32x4*)(outp + ob + bj * HALF + 4) = v1;
                        u32x4 w; w.x = cvt_pk_bf16(v0[0], v0[1]); w.y = cvt_pk_bf16(v0[2], v0[3]); w.z = cvt_pk_bf16(v1[0], v1[1]); w.w = cvt_pk_bf16(v1[2], v1[3]);
                        *(u32x4*)(O + (size_t)row * 3072 + col0 + bj * HALF) = w;
                    }
                    if (m & 1) asm volatile("" ::: "memory");
                }
            return;
        }
        float scr[2][4];
#pragma unroll
        for (int ai = 0; ai < 2; ++ai)
#pragma unroll
            for (int m = 0; m < 4; ++m) {
                const int rl = ai * HALF + wr * 64 + m * 16 + fr;
                const float sc = row_rstd(ss, u.pm * BM + rl); scr[ai][m] = sc;
#pragma unroll
                for (int bj = 0; bj < 2; ++bj) {
                    const f32x4 v0 = acc[ai][bj][m][0] * sc, v1 = acc[ai][bj][m][1] * sc;
                    float s = (v0[0] * v0[0] + v0[1] * v0[1]) + (v0[2] * v0[2] + v0[3] * v0[3]) + (v1[0] * v1[0] + v1[1] * v1[1]) + (v1[2] * v1[2] + v1[3] * v1[3]);
                    s += __shfl_xor(s, 16); s += __shfl_xor(s, 32);
                    if (fq == 0) part[(rl * 2 + bj) * 4 + wc] = s;
                }
            }
        asm volatile("s_waitcnt lgkmcnt(0)" ::: "memory"); __builtin_amdgcn_s_barrier(); asm volatile("" ::: "memory");
        const float* gp = (kind == 0 ? kn : qn) + wc * 32 + 8 * fq;
        const float gm = kind == 0 ? 1.0f : qscale;
        const f32x4 g0 = *(const f32x4*)gp * gm, g1 = *(const f32x4*)(gp + 4) * gm;
#pragma unroll
        for (int ai = 0; ai < 2; ++ai)
#pragma unroll
            for (int m = 0; m < 4; ++m) {
                const int rl = ai * HALF + wr * 64 + m * 16 + fr, row = u.pm * BM + rl;
                const size_t ob = (row < mp ? o_pk + (size_t)row * 1024 : o_sk + (size_t)(row - mp) * 1024) + hcol;
#pragma unroll
                for (int bj = 0; bj < 2; ++bj) {
                    const f32x4 ps = *(const PG8_LAS f32x4*)(part + (rl * 2 + bj) * 4);
                    const float rs = __builtin_amdgcn_rsqf(((ps[0] + ps[1]) + (ps[2] + ps[3])) * (1.0f / 128.0f) + 1e-6f) * scr[ai][m];
                    const f32x4 v0 = acc[ai][bj][m][0] * rs * g0, v1 = acc[ai][bj][m][1] * rs * g1;
                    if (kind == 0) { *(f32x4*)(outp + ob + bj * HALF) = v0; *(f32x4*)(outp + ob + bj * HALF + 4) = v1; }
                    u32x4 w; w.x = cvt_pk_bf16(v0[0], v0[1]); w.y = cvt_pk_bf16(v0[2], v0[3]); w.z = cvt_pk_bf16(v1[0], v1[1]); w.w = cvt_pk_bf16(v1[2], v1[3]);
                    *(u32x4*)(O + (size_t)row * 3072 + col0 + bj * HALF) = w;
                }
                if (m & 1) asm volatile("" ::: "memory");
            }
    }
};
template <class Epi, class Sched, bool ALIGN_EPI = false, bool SP2 = false>
__device__ __forceinline__ void gemm_phase(PG8_LAS unsigned char* lds, const Gemm g, const Sched& S, const Epi& E) {
    int tid = threadIdx.x; asm volatile("" : "+v"(tid)); const int wid = __builtin_amdgcn_readfirstlane(tid >> 6), lane = tid & 63, wr = wid >> 2, wc = wid & 3, fr = lane & 15, fq = lane >> 4;
    const int K = g.K, nt = K / BK;
    unsigned voffA[2], voffB[2];
#pragma unroll
    for (int i = 0; i < 2; ++i) { int R, C; stage_rc(tid * 16 + i * 8192, R, C); const int Rb = Epi::PERM ? ((R & ~31) + perm32(R & 31)) : R;
        voffA[i] = (unsigned)(R * g.lda + C) * 2u; voffB[i] = (unsigned)(Rb * K + C) * 2u; }
    const size_t kstep = (size_t)(BK * 2);
    const size_t hstep = (size_t)HALF * K * 2;
    const size_t tstep = 2 * hstep; const size_t hstepA = (size_t)HALF * g.lda * 2, tstepA = 2 * hstepA;
    const unsigned ldsw = (unsigned)wid * 1024u;
    const int aoff = lds_byte(wr * 64 + fr, fq * 8), boff = lds_byte(wc * 32 + fr, fq * 8);
#define PG8_SA(b, h) (((b) * 2 + (h)) * HTB)
#define PG8_SB(b, h) ((4 + (b) * 2 + (h)) * HTB)
#define PG8_STAGE(bufoff, gbase, voff) do { _Pragma("unroll") for (int _i = 0; _i < 2; ++_i) \
        __builtin_amdgcn_global_load_lds((const unsigned*)((const char*)(gbase) + (voff)[_i]), (PG8_LAS unsigned*)(lds + (bufoff) + ldsw + _i * 8192), 16, 0, 0); } while (0)
#define PG8_LDA(dst, b, h) do { _Pragma("unroll") for (int m = 0; m < 4; ++m) _Pragma("unroll") for (int k = 0; k < 2; ++k) dst[m][k] = *(const PG8_LAS bf16x8*)(lds + PG8_SA(b, h) + aoff + m * 2048 + k * 1024); } while (0)
#define PG8_LDB(dst, b, h) do { _Pragma("unroll") for (int n = 0; n < 2; ++n) _Pragma("unroll") for (int k = 0; k < 2; ++k) dst[n][k] = *(const PG8_LAS bf16x8*)(lds + PG8_SB(b, h) + boff + n * 2048 + k * 1024); } while (0)
#define PG8_MMA(ai, bj, At, Bt) do { __builtin_amdgcn_s_setprio(1); _Pragma("unroll") for (int m = 0; m < 4; ++m) _Pragma("unroll") for (int n = 0; n < 2; ++n) _Pragma("unroll") for (int k = 0; k < 2; ++k) \
        acc[ai][bj][m][n] = __builtin_amdgcn_mfma_f32_16x16x32_bf16(Bt[n][k], At[m][k], acc[ai][bj][m][n], 0, 0, 0); __builtin_amdgcn_s_setprio(0); } while (0)
#define PG8_WAIT_V(n) asm volatile("s_waitcnt vmcnt(" #n ")" ::: "memory")
#define PG8_WAIT_L(n) asm volatile("s_waitcnt lgkmcnt(" #n ")" ::: "memory")
#define PG8_BAR __builtin_amdgcn_s_barrier()
#define PG8_SCHED __builtin_amdgcn_sched_barrier(0)
    Unit cur, nxt; int ui = 0;
    if (!S.next(0, cur)) return;
    f32x4 acc[2][2][4][2];
#pragma unroll
    for (int a = 0; a < 2; ++a)
#pragma unroll
        for (int b = 0; b < 2; ++b)
#pragma unroll
            for (int m = 0; m < 4; ++m)
#pragma unroll
                for (int n = 0; n < 2; ++n) acc[a][b][m][n] = (f32x4){0.f, 0.f, 0.f, 0.f};
    bf16x8 At[4][2], B0[2][2], B1[2][2];
    const char* cA = (const char*)g.A + (size_t)cur.pm * tstepA; const char* cB = (const char*)g.Bt + (size_t)cur.pn * tstep;
    S.a_ready(cur);
    if constexpr (SP2) {
        PG8_STAGE(PG8_SB(0, 0), cB, voffB); PG8_STAGE(PG8_SB(0, 1), cB + hstep, voffB); PG8_STAGE(PG8_SA(0, 0), cA, voffA); PG8_STAGE(PG8_SA(0, 1), cA + hstepA, voffA);
        if (wr == 1) PG8_BAR;
        PG8_WAIT_V(2); PG8_BAR;
        PG8_STAGE(PG8_SB(1, 0), cB + kstep, voffB); PG8_STAGE(PG8_SA(1, 0), cA + kstep, voffA); PG8_STAGE(PG8_SB(1, 1), cB + hstep + kstep, voffB);
        PG8_WAIT_V(6); PG8_BAR;
    } else {
        PG8_STAGE(PG8_SB(0, 0), cB, voffB); PG8_STAGE(PG8_SA(0, 0), cA, voffA); PG8_STAGE(PG8_SB(0, 1), cB + hstep, voffB); PG8_STAGE(PG8_SA(0, 1), cA + hstepA, voffA);
        if (wr == 1) PG8_BAR;
        PG8_WAIT_V(4); PG8_BAR;
        PG8_STAGE(PG8_SB(1, 0), cB + kstep, voffB); PG8_STAGE(PG8_SA(1, 0), cA + kstep, voffA); PG8_STAGE(PG8_SB(1, 1), cB + hstep + kstep, voffB);
        PG8_WAIT_V(6); PG8_BAR;
    }
    for (;;) {
        const bool has_next = S.next(ui + 1, nxt);
        const char* nA = has_next ? (const char*)g.A + (size_t)nxt.pm * tstepA : cA; const char* nB = has_next ? (const char*)g.Bt + (size_t)nxt.pn * tstep : cB;
        for (int t = 0; t < nt; t += 2) {
            const bool last = (t == nt - 2);
            const char* a1 = cA + (size_t)(t + 1) * kstep;
            const char* a2 = last ? nA : cA + (size_t)(t + 2) * kstep; const char* b2 = last ? nB : cB + (size_t)(t + 2) * kstep;
            const char* a3 = a2 + kstep; const char* b3 = b2 + kstep;
            if (last && has_next) S.a_ready(nxt);
            if constexpr (SP2) {
            PG8_LDB(B0, 0, 0); PG8_LDB(B1, 0, 1); PG8_SCHED; PG8_LDA(At, 0, 0); PG8_STAGE(PG8_SA(1, 1), a1 + hstepA, voffA);
            PG8_WAIT_V(8); PG8_WAIT_L(0); PG8_BAR; PG8_MMA(0, 0, At, B0); PG8_MMA(0, 1, At, B1); PG8_BAR; PG8_SCHED;
            PG8_LDA(At, 0, 1); PG8_STAGE(PG8_SB(0, 0), b2, voffB); PG8_STAGE(PG8_SB(0, 1), b2 + hstep, voffB); PG8_STAGE(PG8_SA(0, 0), a2, voffA);
            PG8_WAIT_V(8); PG8_WAIT_L(0); PG8_BAR; PG8_MMA(1, 0, At, B0); PG8_MMA(1, 1, At, B1); PG8_BAR; PG8_SCHED;
            PG8_LDB(B0, 1, 0); PG8_LDB(B1, 1, 1); PG8_SCHED; PG8_LDA(At, 1, 0); PG8_STAGE(PG8_SA(0, 1), a2 + hstepA, voffA);
            PG8_WAIT_V(8); PG8_WAIT_L(0); PG8_BAR; PG8_MMA(0, 0, At, B0); PG8_MMA(0, 1, At, B1); PG8_BAR; PG8_SCHED;
            PG8_LDA(At, 1, 1); PG8_STAGE(PG8_SB(1, 0), b3, voffB); PG8_STAGE(PG8_SB(1, 1), b3 + hstep, voffB); PG8_STAGE(PG8_SA(1, 0), a3, voffA);
            PG8_WAIT_V(8); PG8_WAIT_L(0); PG8_BAR; PG8_MMA(1, 0, At, B0); PG8_MMA(1, 1, At, B1); PG8_BAR; PG8_SCHED;
            } else {
            PG8_LDB(B0, 0, 0); PG8_SCHED; PG8_LDA(At, 0, 0); PG8_STAGE(PG8_SA(1, 1), a1 + hstepA, voffA);
            PG8_WAIT_L(8); PG8_BAR; PG8_WAIT_L(0); PG8_MMA(0, 0, At, B0); PG8_BAR; PG8_SCHED;
            PG8_LDB(B1, 0, 1); PG8_STAGE(PG8_SB(0, 0), b2, voffB);
            PG8_BAR; PG8_WAIT_L(0); PG8_MMA(0, 1, At, B1); PG8_BAR;
            PG8_LDA(At, 0, 1); PG8_STAGE(PG8_SA(0, 0), a2, voffA);
            PG8_BAR; PG8_WAIT_L(0); PG8_MMA(1, 0, At, B0); PG8_BAR; PG8_SCHED;
            PG8_STAGE(PG8_SB(0, 1), b2 + hstep, voffB);
            PG8_WAIT_V(6); PG8_BAR; PG8_MMA(1, 1, At, B1); PG8_BAR;
            PG8_LDB(B0, 1, 0); PG8_SCHED; PG8_LDA(At, 1, 0); PG8_STAGE(PG8_SA(0, 1), a2 + hstepA, voffA);
            PG8_WAIT_L(8); PG8_BAR; PG8_WAIT_L(0); PG8_MMA(0, 0, At, B0); PG8_BAR; PG8_SCHED;
            PG8_LDB(B1, 1, 1); PG8_STAGE(PG8_SB(1, 0), b3, voffB);
            PG8_BAR; PG8_WAIT_L(0); PG8_MMA(0, 1, At, B1); PG8_BAR;
            PG8_LDA(At, 1, 1); PG8_STAGE(PG8_SA(1, 0), a3, voffA);
            PG8_BAR; PG8_WAIT_L(0); PG8_MMA(1, 0, At, B0); PG8_BAR; PG8_SCHED;
            PG8_STAGE(PG8_SB(1, 1), b3 + hstep, voffB);
            PG8_WAIT_V(6); PG8_BAR; PG8_MMA(1, 1, At, B1); PG8_BAR;
            }
        }
        if constexpr (ALIGN_EPI) { if (wr == 0) PG8_BAR; }
        if constexpr (!Epi::AFTER_DRAIN) { E(acc, cur, wr, wc, fr, fq); S.done(cur); }
        if (!has_next) break;
#pragma unroll
        for (int a = 0; a < 2; ++a)
#pragma unroll
            for (int b = 0; b < 2; ++b)
#pragma unroll
                for (int m = 0; m < 4; ++m)
#pragma unroll
                    for (int n = 0; n < 2; ++n) acc[a][b][m][n] = (f32x4){0.f, 0.f, 0.f, 0.f};
        cur = nxt; cA = nA; cB = nB; ++ui;
        if constexpr (ALIGN_EPI) { if (wr == 1) PG8_BAR; }
    }
    PG8_WAIT_V(0);
    if constexpr (!ALIGN_EPI) { if (wr == 0) PG8_BAR; }
    PG8_BAR;
    if constexpr (Epi::AFTER_DRAIN) { E.fused(acc, cur, wr, wc, fr, fq, lds, wid, lane); S.done(cur); }
#undef PG8_SA
#undef PG8_SB
#undef PG8_STAGE
#undef PG8_LDA
#undef PG8_LDB
#undef PG8_MMA
#undef PG8_WAIT_V
#undef PG8_WAIT_L
#undef PG8_BAR
#undef PG8_SCHED
}
}

struct Params { const float* in[30]; float* out; unsigned char* ws; };
typedef const __attribute__((address_space(4))) Params* PP;

DI int otid() { int t = threadIdx.x; asm volatile("" : "+v"(t)); return t; }
DI int obid() { int t = blockIdx.x; asm volatile("" : "+s"(t)); return t; }
DI int ogrid() { int t = gridDim.x; asm volatile("" : "+s"(t)); return t; }
#define LDS_WAIT() asm volatile("s_waitcnt lgkmcnt(0)" ::: "memory")
#define MFMA16(a, b, c) __builtin_amdgcn_mfma_f32_16x16x32_bf16((a), (b), (c), 0, 0, 0)
#define MFMA32(a, b, c) __builtin_amdgcn_mfma_f32_32x32x16_bf16((a), (b), (c), 0, 0, 0)

template <bool FFN_PERM = false>
DI void p0_transpose_item(const float* W, const float* gk, int K, int N, bf16_t* WT, int row_off, LAS float* scr, int item, int lane) {
    const int nblk = N / 32, kb = item / nblk, nb = item % nblk, k0 = 64 * kb, n0 = 32 * nb;
    if (FFN_PERM) { const int j = n0 < 3072 ? n0 : n0 - 3072; row_off = (j >> 7) * 256 + (n0 < 3072 ? 0 : 128) + (j & 127) - n0; }
#pragma unroll 8
    for (int i = 0; i < 32; ++i) { const int kk = 2 * i + (lane >> 5); const float gv = gk ? gk[k0 + kk] : 1.0f; scr[kk * 33 + (lane & 31)] = __builtin_nontemporal_load(&W[(size_t)(k0 + kk) * N + n0 + (lane & 31)]) * gv; }
    LDS_WAIT(); asm volatile("" ::: "memory");
    const int c = lane & 7;
#pragma unroll
    for (int j = 0; j < 4; ++j) { const int n = (lane >> 3) + 8 * j; const LAS float* s = scr + (8 * c) * 33 + n;
        u32x4 o; o.x = pk2(s[0 * 33], s[1 * 33]); o.y = pk2(s[2 * 33], s[3 * 33]); o.z = pk2(s[4 * 33], s[5 * 33]); o.w = pk2(s[6 * 33], s[7 * 33]);
        *(u32x4*)(WT + (size_t)(row_off + n0 + n) * K + k0 + 8 * c) = o; }
    LDS_WAIT(); asm volatile("" ::: "memory");
}
DI void phase0(PP pp, LAS unsigned char* lds, int lane, int wave) {
    LAS float* scr = (LAS float*)(lds + wave * 16384);
    const int gw = obid() * 8 + wave, NGW = ogrid() * 8;
    unsigned char* ws = pp->ws;
    for (int it = gw; it < 12864; it += NGW) {
        int r = it;
        if (r < 1024) { p0_transpose_item(pp->in[8], pp->in[7], 1024, 2048, (bf16_t*)(ws + WS_WIN), 0, scr, r, lane); continue; } r -= 1024;
        if (r < 512) { p0_transpose_item(pp->in[16], nullptr, 1024, 1024, (bf16_t*)(ws + WS_WOUT), 0, scr, r, lane); continue; } r -= 512;
        if (r < 3072) { p0_transpose_item<true>(pp->in[25], pp->in[24], 1024, 6144, (bf16_t*)(ws + WS_WUP0), 0, scr, r, lane); continue; } r -= 3072;
        if (r < 3072) { p0_transpose_item<true>(pp->in[25] + (size_t)1024 * 6144, pp->in[24] + 1024, 1024, 6144, (bf16_t*)(ws + WS_WUP1), 0, scr, r, lane); continue; } r -= 3072;
        if (r < 1536) { p0_transpose_item(pp->in[28], nullptr, 3072, 1024, (bf16_t*)(ws + WS_WDN0), 0, scr, r, lane); continue; } r -= 1536;
        if (r < 1536) { p0_transpose_item(pp->in[28] + (size_t)3072 * 1024, nullptr, 3072, 1024, (bf16_t*)(ws + WS_WDN1), 0, scr, r, lane); continue; } r -= 1536;
        if (r < 1024) { p0_transpose_item(pp->in[18], pp->in[17], 1024, 2048, (bf16_t*)(ws + WS_WQKV), 0, scr, r, lane); continue; } r -= 1024;
        if (r < 512) { p0_transpose_item(pp->in[21], pp->in[20], 1024, 1024, (bf16_t*)(ws + WS_WQKV), 2048, scr, r, lane); continue; } r -= 512;
        if (r < 512) { p0_transpose_item(pp->in[23], nullptr, 1024, 1024, (bf16_t*)(ws + WS_WO), 0, scr, r, lane); continue; } r -= 512;
        if (r < 32) { const int blk = r >> 1; p0_transpose_item(pp->in[11] + blk * 4096, nullptr, 64, 64, (bf16_t*)(ws + WS_WRT) + blk * 4096, 0, scr, r & 1, lane); continue; } r -= 32;
        { const int blk = r >> 1; p0_transpose_item(pp->in[13] + blk * 4096, nullptr, 64, 64, (bf16_t*)(ws + WS_WIT) + blk * 4096, 0, scr, r & 1, lane); }
    }
    bf16_t* XB = (bf16_t*)(ws + WS_XB);
    float* SSp = (float*)(ws + WS_SS);
    for (int m4 = gw * 4; m4 < M; m4 += NGW * 4) {
        const float* xbase = m4 < MP ? pp->in[0] + (size_t)m4 * D : pp->in[1] + (size_t)(m4 - MP) * D;
        f32x4 v[4][4];
#pragma unroll
        for (int r = 0; r < 4; ++r)
#pragma unroll
            for (int j = 0; j < 4; ++j) v[r][j] = __builtin_nontemporal_load((const f32x4*)(xbase + (size_t)r * D) + lane + 64 * j);
#pragma unroll
        for (int r = 0; r < 4; ++r) {
            float s = 0.f;
            u32x2* o8 = (u32x2*)(XB + (size_t)(m4 + r) * D) + lane;
#pragma unroll
            for (int j = 0; j < 4; ++j) { s += (v[r][j][0] * v[r][j][0] + v[r][j][1] * v[r][j][1]) + (v[r][j][2] * v[r][j][2] + v[r][j][3] * v[r][j][3]);
                u32x2 w; w.x = pk2(v[r][j][0], v[r][j][1]); w.y = pk2(v[r][j][2], v[r][j][3]); o8[64 * j] = w; }
            s = wave_sum(s);
            if (lane < 4) *((f32x4*)(SSp + (size_t)(m4 + r) * 16) + lane) = (f32x4){lane == 0 ? s : 0.f, 0.f, 0.f, 0.f};
        }
    }
}

DI void lru_phase(PP pp, LAS unsigned char* lds, int tid, int lane, int wave) {
    const bf16_t* GR = (const bf16_t*)(pp->ws + WS_BIG);
    bf16_t* HG = (bf16_t*)(pp->ws + WS_BIG + (size_t)M * 2048 * 2);
    const bf16_t* WRT = (const bf16_t*)(pp->ws + WS_WRT); const bf16_t* WIT = (const bf16_t*)(pp->ws + WS_WIT);
    LAS unsigned char* sWr = lds; LAS unsigned char* sWi = lds + 9216; LAS unsigned char* sCb = lds + 18432;
    LAS float* sA = (LAS float*)(lds + 36864); LAS float* sB = (LAS float*)(lds + 69632);
    LAS float* segA = (LAS float*)(lds + 102400); LAS float* segB = (LAS float*)(lds + 104448);
    LAS float* carry = (LAS float*)(lds + 106496); LAS float* par = (LAS float*)(lds + 106752);
#if defined(PROBE_L2B)
    for (int unit_ = obid(); unit_ < 1536; unit_ += ogrid()) { const int unit = unit_ >= 768 ? unit_ - 768 : unit_;
#else
    for (int unit = obid(); unit < 768; unit += ogrid()) {
#endif
        const bool smp = unit >= 512; const int su = smp ? unit - 512 : unit; const int b = su >> 4, n = su & 15;
        const int m0 = smp ? MP + b * DT : b * T; const int TT = smp ? DT : T;
        float* out_h = pp->out + (smp ? O_SH : O_PH) + (size_t)b * D + n * 64;
        float* out_c = pp->out + (smp ? O_SC : O_PC) + (size_t)b * 3 * D + n * 64;
        const float* st_conv = pp->in[3] + (size_t)b * 3 * D + n * 64;
        if (tid < 64) {
            const int ch = n * 64 + tid;
#pragma unroll
            for (int k = 0; k < 4; ++k) par[k * 64 + tid] = pp->in[9][k * 1024 + ch];
            par[4 * 64 + tid] = pp->in[10][ch]; par[5 * 64 + tid] = pp->in[12][ch]; par[6 * 64 + tid] = pp->in[14][ch];
            const float lam = pp->in[15][ch];
            par[7 * 64 + tid] = 8.0f * (fminf(lam, 0.f) - log1pf(expf(-fabsf(lam))));
            carry[tid] = smp ? pp->in[2][(size_t)b * D + ch] : 0.f;
        }
        { const int row = tid >> 3, ck = tid & 7;
          *(LAS u32x4*)(sWr + row * 144 + ck * 16) = *(const u32x4*)(WRT + n * 4096 + row * 64 + ck * 8);
          *(LAS u32x4*)(sWi + row * 144 + ck * 16) = *(const u32x4*)(WIT + n * 4096 + row * 64 + ck * 8); }
        __syncthreads();
        const int nch = (TT + 127) >> 7;
        u32x4 xr[2][4], gtv[2];
#define LRU_LOAD_REC(t0_) do { _Pragma("unroll") for (int i = 0; i < 2; ++i) { const int item = tid + 512 * i, tl = item >> 3, gq = item & 7, t = (t0_) + tl; \
            _Pragma("unroll") for (int k = 0; k < 4; ++k) { const int tt = t - 3 + k; \
                if (t < TT && tt >= 0) xr[i][k] = *(const u32x4*)(GR + (size_t)(m0 + tt) * 2048 + 1024 + n * 64 + gq * 8); \
                else if (t < TT && smp) { const float* sp = st_conv + (size_t)(tt + 3) * D + gq * 8; const f32x4 a = *(const f32x4*)sp, bq = *(const f32x4*)(sp + 4); \
                    xr[i][k].x = pk2(a[0], a[1]); xr[i][k].y = pk2(a[2], a[3]); xr[i][k].z = pk2(bq[0], bq[1]); xr[i][k].w = pk2(bq[2], bq[3]); } \
                else xr[i][k] = (u32x4){0u, 0u, 0u, 0u}; } } } while (0)
        LRU_LOAD_REC(0);
        for (int ck = 0; ck < nch; ++ck) {
            const int t0 = ck << 7;
#pragma unroll
            for (int i = 0; i < 2; ++i) { const int item = tid + 512 * i, tl = item >> 3, gq = item & 7, t = t0 + tl;
                gtv[i] = (t < TT) ? *(const u32x4*)(GR + (size_t)(m0 + t) * 2048 + n * 64 + gq * 8) : (u32x4){0u, 0u, 0u, 0u}; }
#pragma unroll
            for (int i = 0; i < 2; ++i) {
                const int item = tid + 512 * i, tl = item >> 3, gq = item & 7, t = t0 + tl;
                float c[8];
                if (t < TT) {
                    float x3[8];
#pragma unroll
                    for (int e = 0; e < 8; ++e) c[e] = par[4 * 64 + gq * 8 + e];
#pragma unroll
                    for (int k = 0; k < 4; ++k) {
                        float xv[8]; unpack8(xr[i][k], xv);
#pragma unroll
                        for (int e = 0; e < 8; ++e) c[e] += par[k * 64 + gq * 8 + e] * xv[e];
                        if (k == 3) {
#pragma unroll
                            for (int e = 0; e < 8; ++e) x3[e] = xv[e]; }
                    }
                    if (t >= TT - 3) { float* o = out_c + (size_t)(t - (TT - 3)) * D + gq * 8;
                        *(f32x4*)o = (f32x4){x3[0], x3[1], x3[2], x3[3]}; *(f32x4*)(o + 4) = (f32x4){x3[4], x3[5], x3[6], x3[7]}; }
                } else {
#pragma unroll
                    for (int e = 0; e < 8; ++e) c[e] = 0.f;
                }
                *(LAS f32x4*)(sB + tl * 64 + gq * 8) = (f32x4){c[0], c[1], c[2], c[3]};
                *(LAS f32x4*)(sB + tl * 64 + gq * 8 + 4) = (f32x4){c[4], c[5], c[6], c[7]};
                *(LAS u32x4*)(sCb + tl * 144 + gq * 16) = pack8(c);
            }
            if (ck + 1 < nch) LRU_LOAD_REC(t0 + 128);
            __syncthreads();
            {
                const int l16 = lane & 15, q4 = lane >> 4;
                bf16x8 af[2];
#pragma unroll
                for (int ks = 0; ks < 2; ++ks) af[ks] = *(const LAS bf16x8*)(sCb + (16 * wave + l16) * 144 + (ks * 32 + q4 * 8) * 2);
#pragma unroll
                for (int nt = 0; nt < 4; ++nt) {
                    f32x4 ar = {0.f, 0.f, 0.f, 0.f}, ai = {0.f, 0.f, 0.f, 0.f};
#pragma unroll
                    for (int ks = 0; ks < 2; ++ks) {
                        const bf16x8 b1 = *(const LAS bf16x8*)(sWr + (16 * nt + l16) * 144 + (ks * 32 + q4 * 8) * 2);
                        const bf16x8 b2 = *(const LAS bf16x8*)(sWi + (16 * nt + l16) * 144 + (ks * 32 + q4 * 8) * 2);
                        ar = MFMA16(af[ks], b1, ar); ai = MFMA16(af[ks], b2, ai);
                    }
                    const int e = 16 * nt + l16; const float br_ = par[5 * 64 + e], bi_ = par[6 * 64 + e], cl = par[7 * 64 + e];
#pragma unroll
                    for (int j = 0; j < 4; ++j) {
                        const int tl = 16 * wave + 4 * q4 + j;
                        const float r = sigmoidf_(ar[j] + br_), ig = sigmoidf_(ai[j] + bi_), la = r * cl;
                        const float a = fexp2(la * LOG2E), x2 = 2.0f * la;
                        const float em_s = -x2 * (1.0f + x2 * (0.5f + x2 * (0.16666667f + x2 * (0.041666668f + x2 * 0.0083333338f)))), em_l = 1.0f - a * a;
                        const float bt = __builtin_amdgcn_sqrtf(x2 > -0.25f ? em_s : em_l) * ig * sB[tl * 64 + e];
                        sA[tl * 64 + e] = a; sB[tl * 64 + e] = bt;
                    }
                }
            }
            __syncthreads();
            {
                const int ch = tid & 63, seg = wave;
                float Aacc = 1.f, Bacc = 0.f;
#pragma unroll
                for (int k = 0; k < 16; ++k) { const int tl = 16 * seg + k; const float a = sA[tl * 64 + ch], bq = sB[tl * 64 + ch]; Bacc = a * Bacc + bq; Aacc *= a; }
                segA[seg * 64 + ch] = Aacc; segB[seg * 64 + ch] = Bacc;
                __syncthreads();
                float h = carry[ch];
                for (int s = 0; s < seg; ++s) h = segA[s * 64 + ch] * h + segB[s * 64 + ch];
#pragma unroll
                for (int k = 0; k < 16; ++k) { const int tl = 16 * seg + k; h = sA[tl * 64 + ch] * h + sB[tl * 64 + ch]; sB[tl * 64 + ch] = h; }
                __syncthreads();
                if (seg == 7) carry[ch] = h;
            }
#pragma unroll
            for (int i = 0; i < 2; ++i) {
                const int item = tid + 512 * i, tl = item >> 3, gq = item & 7, t = t0 + tl;
                if (t < TT) {
                    float g[8], o[8]; unpack8(gtv[i], g);
                    const f32x4 h0 = *(const LAS f32x4*)(sB + tl * 64 + gq * 8), h1 = *(const LAS f32x4*)(sB + tl * 64 + gq * 8 + 4);
                    const float h[8] = {h0[0], h0[1], h0[2], h0[3], h1[0], h1[1], h1[2], h1[3]};
#pragma unroll
                    for (int e = 0; e < 8; ++e) o[e] = h[e] * gelu_tanh(g[e]);
                    *(u32x4*)(HG + (size_t)(m0 + t) * 1024 + n * 64 + gq * 8) = pack8(o);
                    if (t == TT - 1) { *(f32x4*)(out_h + gq * 8) = h0; *(f32x4*)(out_h + gq * 8 + 4) = h1; }
                }
            }
            __syncthreads();
        }
    }
}

DI void ffn_fix_phase(PP pp, int layer, int tid) {
    bf16_t* H = (bf16_t*)(pp->ws + WS_BIG);
    const bf16_t* EG = (const bf16_t*)(pp->ws + WS_BIG + (size_t)M * 6144);
    const bf16_t* EU = EG + (size_t)(M / 16) * 4 * 3072;
    const float* cw = pp->in[26] + (size_t)layer * 3 * DFF; const float* cb = pp->in[27] + (size_t)layer * DFF;
    float* outp = pp->out;
    const int gt = obid() * 512 + tid, NT = ogrid() * 512;
    for (int it = gt; it < (M / 16) * 384; it += NT) {
        const int grp = it / 384, j0 = (it - grp * 384) * 8;
        const bool smp = grp >= MP / 16; int b, t0;
        if (!smp) { b = grp >> 7; t0 = (grp & 127) << 4; } else { b = grp - MP / 16; t0 = 0; }
        const u32x4 e0 = *(const u32x4*)(EG + ((size_t)grp * 4 + 0) * 3072 + j0), e1 = *(const u32x4*)(EG + ((size_t)grp * 4 + 1) * 3072 + j0),
                    e2 = *(const u32x4*)(EG + ((size_t)grp * 4 + 2) * 3072 + j0), e3 = *(const u32x4*)(EG + ((size_t)grp * 4 + 3) * 3072 + j0),
                    q0 = *(const u32x4*)(EU + ((size_t)grp * 2 + 0) * 3072 + j0), q1 = *(const u32x4*)(EU + ((size_t)grp * 2 + 1) * 3072 + j0);
        float w0[8], w1[8], w2[8], bb[8], gm2[8], gm1[8], g0[8], g1[8], u0[8], u1[8], h0[8], h1[8];
        { const f32x4 a = *(const f32x4*)(cw + j0), a2 = *(const f32x4*)(cw + j0 + 4), b1 = *(const f32x4*)(cw + DFF + j0), b2 = *(const f32x4*)(cw + DFF + j0 + 4),
                      c1 = *(const f32x4*)(cw + 2 * DFF + j0), c2 = *(const f32x4*)(cw + 2 * DFF + j0 + 4), d1 = *(const f32x4*)(cb + j0), d2 = *(const f32x4*)(cb + j0 + 4);
#pragma unroll
          for (int e = 0; e < 4; ++e) { w0[e] = a[e]; w0[e + 4] = a2[e]; w1[e] = b1[e]; w1[e + 4] = b2[e]; w2[e] = c1[e]; w2[e + 4] = c2[e]; bb[e] = d1[e]; bb[e + 4] = d2[e]; } }
        if (t0 > 0) { unpack8(*(const u32x4*)(EG + ((size_t)(grp - 1) * 4 + 0) * 3072 + j0), gm2); unpack8(*(const u32x4*)(EG + ((size_t)(grp - 1) * 4 + 1) * 3072 + j0), gm1); }
        else if (smp) { const float* sp = pp->in[4] + (size_t)(layer * DB + b) * 2 * DFF + j0;
            const f32x4 a = *(const f32x4*)sp, a2 = *(const f32x4*)(sp + 4), c1 = *(const f32x4*)(sp + DFF), c2 = *(const f32x4*)(sp + DFF + 4);
#pragma unroll
            for (int e = 0; e < 4; ++e) { gm2[e] = a[e]; gm2[e + 4] = a2[e]; gm1[e] = c1[e]; gm1[e + 4] = c2[e]; } }
        else {
#pragma unroll
            for (int e = 0; e < 8; ++e) { gm1[e] = 0.f; gm2[e] = 0.f; } }
        unpack8(e2, g0); unpack8(e3, g1); unpack8(q0, u0); unpack8(q1, u1);
#pragma unroll
        for (int e = 0; e < 8; ++e) {
            h0[e] = gelu_tanh(bb[e] + w0[e] * gm2[e] + w1[e] * gm1[e] + w2[e] * g0[e]) * u0[e];
            h1[e] = gelu_tanh(bb[e] + w0[e] * gm1[e] + w1[e] * g0[e] + w2[e] * g1[e]) * u1[e];
        }
        *(u32x4*)(H + (size_t)grp * 16 * 3072 + j0) = pack8(h0);
        *(u32x4*)(H + ((size_t)grp * 16 + 1) * 3072 + j0) = pack8(h1);
        if (smp || t0 == T - 16) {
            float* o = outp + (smp ? O_SF + (size_t)(layer * DB + b) * 2 * DFF : O_PF + (size_t)(layer * NB + b) * 2 * DFF) + j0;
            float s0[8], s1[8]; unpack8(e0, s0); unpack8(e1, s1);
            *(f32x4*)o = (f32x4){s0[0], s0[1], s0[2], s0[3]}; *(f32x4*)(o + 4) = (f32x4){s0[4], s0[5], s0[6], s0[7]};
            *(f32x4*)(o + DFF) = (f32x4){s1[0], s1[1], s1[2], s1[3]}; *(f32x4*)(o + DFF + 4) = (f32x4){s1[4], s1[5], s1[6], s1[7]};
        }
    }
}

DI void headnorm_phase(PP pp, int lane, int wave) {
    bf16_t* QKV = (bf16_t*)(pp->ws + WS_BIG);
    const float* kn = pp->in[19]; const float* qn = pp->in[22];
    const int gw = obid() * 8 + wave, NGW = ogrid() * 8;
    float* outp = pp->out;
    f32x4 kg[2][2], qg[2][2];
#pragma unroll
    for (int it = 0; it < 2; ++it) { const int d0 = ((it * 64 + lane) * 8) & 127;
        kg[it][0] = *(const f32x4*)(kn + d0); kg[it][1] = *(const f32x4*)(kn + d0 + 4); qg[it][0] = *(const f32x4*)(qn + d0) * QSCALE; qg[it][1] = *(const f32x4*)(qn + d0 + 4) * QSCALE; }
    for (int m2 = gw * 2; m2 < M; m2 += NGW * 2) {
        u32x4 kr[2][2], vr[2][2], qr[2][2];
#pragma unroll
        for (int r = 0; r < 2; ++r)
#pragma unroll
            for (int it = 0; it < 2; ++it) { const bf16_t* rp = QKV + (size_t)(m2 + r) * 3072 + (it * 64 + lane) * 8;
                kr[r][it] = *(const u32x4*)rp; vr[r][it] = *(const u32x4*)(rp + 1024); qr[r][it] = *(const u32x4*)(rp + 2048); }
#pragma unroll
        for (int r = 0; r < 2; ++r) {
            const int m = m2 + r;
            bf16_t* row = QKV + (size_t)m * 3072;
            float* ok = m < MP ? outp + O_PK + (size_t)m * D : outp + O_SK + (size_t)(m - MP) * D;
            float* ov = m < MP ? outp + O_PV + (size_t)m * D : outp + O_SV + (size_t)(m - MP) * D;
#pragma unroll
            for (int it = 0; it < 2; ++it) {
                const int col = (it * 64 + lane) * 8;
                float f[8]; float s;
                unpack8(kr[r][it], f); s = 0.f;
#pragma unroll
                for (int e = 0; e < 8; ++e) s += f[e] * f[e];
                s += __shfl_xor(s, 1); s += __shfl_xor(s, 2); s += __shfl_xor(s, 4); s += __shfl_xor(s, 8);
                float rs = __builtin_amdgcn_rsqf(s * (1.f / 128.f) + EPS);
#pragma unroll
                for (int e = 0; e < 4; ++e) { f[e] = f[e] * rs * kg[it][0][e]; f[e + 4] = f[e + 4] * rs * kg[it][1][e]; }
                *(f32x4*)(ok + col) = (f32x4){f[0], f[1], f[2], f[3]}; *(f32x4*)(ok + col + 4) = (f32x4){f[4], f[5], f[6], f[7]};
                *(u32x4*)(row + col) = pack8(f);
                unpack8(vr[r][it], f);
                *(f32x4*)(ov + col) = (f32x4){f[0], f[1], f[2], f[3]}; *(f32x4*)(ov + col + 4) = (f32x4){f[4], f[5], f[6], f[7]};
                unpack8(qr[r][it], f); s = 0.f;
#pragma unroll
                for (int e = 0; e < 8; ++e) s += f[e] * f[e];
                s += __shfl_xor(s, 1); s += __shfl_xor(s, 2); s += __shfl_xor(s, 4); s += __shfl_xor(s, 8);
                rs = __builtin_amdgcn_rsqf(s * (1.f / 128.f) + EPS);
#pragma unroll
                for (int e = 0; e < 4; ++e) { f[e] = f[e] * rs * qg[it][0][e]; f[e + 4] = f[e + 4] * rs * qg[it][1][e]; }
                *(u32x4*)(row + 2048 + col) = pack8(f);
            }
        }
    }
}

constexpr int AT_KP = 272, AT_VP = 136, AT_KB = 64 * AT_KP, AT_VB = 128 * AT_VP, AT_BUF = AT_KB + AT_VB, AT_FLAGS = 2 * AT_BUF;
template <bool SMP>
DI void attn_unit(PP pp, LAS unsigned char* lds, int tid, int lane, int wave, int b, int h, int qb) {
    const bf16_t* QKV = (const bf16_t*)(pp->ws + WS_BIG);
    bf16_t* AO = (bf16_t*)(pp->ws + WS_BIG + (size_t)M * 3072 * 2);
    const int mrow0 = SMP ? MP + b * DT : b * T;
    const int qpos0 = SMP ? PAST : qb * 256;
    const int qrow0 = SMP ? mrow0 : mrow0 + qb * 256;
    const int nq = SMP ? DT : 256;
    const int ntiles = SMP ? (PAST + DT - 2) / 64 + 1 : 4 * qb + 4;
    const int q = lane & 31, hl = lane >> 5, wq0 = 32 * wave;
    const int vhx = 4 * (hl ^ ((q >> 4) & 1));
    const bool wave_valid = wq0 < nq;
    const int myq = wq0 + q; const bool qvalid = myq < nq; const int qpos = qpos0 + myq; const int p_lo = qpos0 + wq0;
    LAS unsigned* sAlive = (LAS unsigned*)(lds + AT_FLAGS);
    bf16x8 qf[8];
    { const bf16_t* qp = QKV + (size_t)(qrow0 + (qvalid ? myq : 0)) * 3072 + 2048 + h * 128 + hl * 8;
#pragma unroll
      for (int s = 0; s < 8; ++s) qf[s] = *(const bf16x8*)(qp + s * 16); }
    f32x16 O[4];
#pragma unroll
    for (int dt = 0; dt < 4; ++dt)
#pragma unroll
        for (int j = 0; j < 16; ++j) O[dt][j] = 0.f;
    float R = 1.f; int wlive = 1;
    const float* ck = pp->in[5]; const float* cv = pp->in[6];
    u32x4 kr[2], vr[2];
#define AT_LOAD(kt_) do { if (!SMP) { _Pragma("unroll") for (int i = 0; i < 2; ++i) { const int c = tid + 512 * i, kl = c >> 4, part = c & 15, s = 64 * (kt_) + kl; \
        const bf16_t* rp = QKV + (size_t)(mrow0 + s) * 3072 + h * 128 + part * 8; kr[i] = *(const u32x4*)rp; vr[i] = *(const u32x4*)(rp + 1024); } } } while (0)
#define AT_STORE(buf_, kt_) do { LAS unsigned char* sK_ = lds + (buf_) * AT_BUF; LAS unsigned char* sV_ = sK_ + AT_KB; \
        _Pragma("unroll") for (int i = 0; i < 2; ++i) { const int c = tid + 512 * i, kl = c >> 4, part = c & 15; u32x4 kk, vv; \
            if (!SMP) { kk = kr[i]; vv = vr[i]; } \
            else { const int s = 64 * (kt_) + kl; \
                if (s < PAST) { const size_t off = (((size_t)b * PAST + s) * NH + h) * HD + part * 8; \
                    const f32x4 k0 = *(const f32x4*)(ck + off), k1 = *(const f32x4*)(ck + off + 4), v0 = *(const f32x4*)(cv + off), v1 = *(const f32x4*)(cv + off + 4); \
                    kk.x = pk2(k0[0], k0[1]); kk.y = pk2(k0[2], k0[3]); kk.z = pk2(k1[0], k1[1]); kk.w = pk2(k1[2], k1[3]); \
                    vv.x = pk2(v0[0], v0[1]); vv.y = pk2(v0[2], v0[3]); vv.z = pk2(v1[0], v1[1]); vv.w = pk2(v1[2], v1[3]); } \
                else if (s < PAST + DT) { const bf16_t* rp = QKV + (size_t)(mrow0 + s - PAST) * 3072 + h * 128 + part * 8; kk = *(const u32x4*)rp; vv = *(const u32x4*)(rp + 1024); } \
                else { kk = (u32x4){0u, 0u, 0u, 0u}; vv = kk; } } \
            *(LAS u32x4*)(sK_ + kl * AT_KP + part * 16) = kk; \
            LAS unsigned short* vp = (LAS unsigned short*)(sV_ + (part * 8) * AT_VP + (kl ^ (4 * (part >> 1))) * 2);     \
            vp[0 * (AT_VP / 2)] = (unsigned short)(vv.x & 0xffffu); vp[1 * (AT_VP / 2)] = (unsigned short)(vv.x >> 16); \
            vp[2 * (AT_VP / 2)] = (unsigned short)(vv.y & 0xffffu); vp[3 * (AT_VP / 2)] = (unsigned short)(vv.y >> 16); \
            vp[4 * (AT_VP / 2)] = (unsigned short)(vv.z & 0xffffu); vp[5 * (AT_VP / 2)] = (unsigned short)(vv.z >> 16); \
            vp[6 * (AT_VP / 2)] = (unsigned short)(vv.w & 0xffffu); vp[7 * (AT_VP / 2)] = (unsigned short)(vv.w >> 16); } } while (0)

    AT_LOAD(ntiles - 1); AT_STORE(0, ntiles - 1);
    __syncthreads();
    int it = 0;
    for (int kt = ntiles - 1; kt >= 0; --kt, ++it) {
        if (kt > 0) AT_LOAD(kt - 1);
        const LAS unsigned char* sK = lds + (it & 1) * AT_BUF; const LAS unsigned char* sVt = sK + AT_KB;
        if (wave_valid && wlive) {
#pragma unroll
            for (int sub = 1; sub >= 0; --sub) {
                const int kbase = 64 * kt + 32 * sub;
                if (kbase <= p_lo + 30) {
                    f32x16 S;
#pragma unroll
                    for (int j = 0; j < 16; ++j) S[j] = 0.f;
#pragma unroll
                    for (int s = 0; s < 8; ++s) { const bf16x8 kf = *(const LAS bf16x8*)(sK + (32 * sub + q) * AT_KP + s * 32 + hl * 16); S = MFMA32(kf, qf[s], S); }
                    float sg[16];
                    if (kbase + 31 >= p_lo) {
#pragma unroll
                        for (int j = 0; j < 16; ++j) {
                            const int key = kbase + 8 * (j >> 2) + 4 * hl + (j & 3);
                            const float v = frcp(1.0f + fexp2(S[j]));
                            sg[j] = key >= qpos ? 1.0f : v;
                        }
                    } else {
#pragma unroll
                        for (int j = 0; j < 16; ++j) sg[j] = frcp(1.0f + fexp2(S[j]));
                    }
                    float Gq[4], pr[4], Tg[4];
#pragma unroll
                    for (int g = 0; g < 4; ++g) { const float gp = (sg[4 * g] * sg[4 * g + 1]) * (sg[4 * g + 2] * sg[4 * g + 3]); Gq[g] = __shfl_xor(gp, 32); pr[g] = gp * Gq[g]; }
                    Tg[3] = 1.f; Tg[2] = pr[3]; Tg[1] = pr[3] * pr[2]; Tg[0] = Tg[1] * pr[1];
                    float w[16];
#pragma unroll
                    for (int g = 0; g < 4; ++g) {
                        float P = R * Tg[g]; if (hl == 0) P *= Gq[g];
                        w[4 * g + 3] = (1.0f - sg[4 * g + 3]) * P; P *= sg[4 * g + 3];
                        w[4 * g + 2] = (1.0f - sg[4 * g + 2]) * P; P *= sg[4 * g + 2];
                        w[4 * g + 1] = (1.0f - sg[4 * g + 1]) * P; P *= sg[4 * g + 1];
                        w[4 * g] = (1.0f - sg[4 * g]) * P;
                    }
                    R = R * Tg[0] * pr[0];
#pragma unroll
                    for (int ks = 0; ks < 2; ++ks) {
                        u32x4 wp; wp.x = pk2(w[8 * ks], w[8 * ks + 1]); wp.y = pk2(w[8 * ks + 2], w[8 * ks + 3]); wp.z = pk2(w[8 * ks + 4], w[8 * ks + 5]); wp.w = pk2(w[8 * ks + 6], w[8 * ks + 7]);
                        const bf16x8 wf = __builtin_bit_cast(bf16x8, wp);
#pragma unroll
                        for (int dt = 0; dt < 4; ++dt) {
                            const LAS unsigned char* vrp = sVt + (32 * dt + q) * AT_VP + vhx * 2;
                            const u32x2 v0 = *(const LAS u32x2*)(vrp + ((32 * sub + 16 * ks) ^ (8 * dt)) * 2), v1 = *(const LAS u32x2*)(vrp + ((32 * sub + 16 * ks + 8) ^ (8 * dt)) * 2);
                            const u32x4 vv = {v0.x, v0.y, v1.x, v1.y};
                            O[dt] = MFMA32(__builtin_bit_cast(bf16x8, vv), wf, O[dt]);
                        }
                    }
                }
            }
        }
        {
            const bool started = wave_valid && (64 * kt <= p_lo + 30);
            const unsigned long long bal = __ballot(qvalid && R != 0.f);
            const unsigned alive = wave_valid ? ((!started || bal != 0ull) ? 1u : 0u) : 0u;
            wlive = __builtin_amdgcn_readfirstlane((int)alive);
            if (lane == 0) sAlive[(it & 1) * 8 + wave] = alive;
        }
        if (kt > 0) AT_STORE((it + 1) & 1, kt - 1);
        __syncthreads();
        unsigned any = 0;
#pragma unroll
        for (int w8 = 0; w8 < 8; ++w8) any |= sAlive[(it & 1) * 8 + w8];
        if (!any) break;
    }
#undef AT_LOAD
#undef AT_STORE
    if (wave_valid && qvalid) {
        bf16_t* orow = AO + (size_t)(qrow0 + myq) * 1024 + h * 128 + 4 * hl;
#pragma unroll
        for (int dt = 0; dt < 4; ++dt)
#pragma unroll
            for (int g = 0; g < 4; ++g) { u32x2 w; w.x = pk2(O[dt][4 * g], O[dt][4 * g + 1]); w.y = pk2(O[dt][4 * g + 2], O[dt][4 * g + 3]); *(u32x2*)(orow + 32 * dt + 8 * g) = w; }
    }
}
DI void attn_phase(PP pp, LAS unsigned char* lds, int tid, int lane, int wave) {
    for (int u = obid(); u < 128 + 2048; u += ogrid()) {
        if (u < 128) attn_unit<true>(pp, lds, tid, lane, wave, u >> 3, u & 7, 0);
        else { const int v = u - 128, qb = 7 - (v >> 8), rem = v & 255; attn_unit<false>(pp, lds, tid, lane, wave, rem >> 3, rem & 7, qb); }
        __syncthreads();
    }
}

DI void final_phase(PP pp, int lane, int wave) {
    const int gw = obid() * 8 + wave, NGW = ogrid() * 8; const float* gn = pp->in[29];
    const bf16_t* XB = (const bf16_t*)(pp->ws + WS_XB);
    f32x4 gv[4];
#pragma unroll
    for (int j = 0; j < 4; ++j) gv[j] = *((const f32x4*)gn + lane + 64 * j);
    float* outp = pp->out;
    for (int m4 = gw * 4; m4 < M; m4 += NGW * 4) {
        u32x2 raw[4][4];
#pragma unroll
        for (int r = 0; r < 4; ++r)
#pragma unroll
            for (int j = 0; j < 4; ++j) raw[r][j] = __builtin_nontemporal_load((const u32x2*)(XB + (size_t)(m4 + r) * D) + lane + 64 * j);
#pragma unroll
        for (int r = 0; r < 4; ++r) {
            f32x4 v[4]; float s = 0.f;
#pragma unroll
            for (int j = 0; j < 4; ++j) { v[j] = (f32x4){bflo(raw[r][j].x), bfhi(raw[r][j].x), bflo(raw[r][j].y), bfhi(raw[r][j].y)};
                s += (v[j][0] * v[j][0] + v[j][1] * v[j][1]) + (v[j][2] * v[j][2] + v[j][3] * v[j][3]); }
            const float rstd = __builtin_amdgcn_rsqf(wave_sum(s) * (1.f / D) + EPS);
#pragma unroll
            for (int j = 0; j < 4; ++j) *((f32x4*)(outp + (size_t)(m4 + r) * D) + lane + 64 * j) = v[j] * rstd * gv[j];
        }
    }
}

#define XB_TMO      128
#define XB_XCNT(j)  (256  + 64 * (j))
#define XB_XSUB(j)  (1280 + 64 * (j))
#define XB_XGEN(j)  (2304 + 64 * (j))
#define XB_TOP      3328
#define XB_TOPGEN   3392
#define XCD_BAR_WORDS 3456
#define XB_SPIN_CAP (1u << 18)

__device__ __forceinline__ unsigned xb_ld(unsigned* p)              { return __hip_atomic_load(p, __ATOMIC_RELAXED, __HIP_MEMORY_SCOPE_AGENT); }
__device__ __forceinline__ unsigned xb_add(unsigned* p, unsigned v) { return __hip_atomic_fetch_add(p, v, __ATOMIC_RELAXED, __HIP_MEMORY_SCOPE_AGENT); }
__device__ __forceinline__ unsigned xb_xcc_id() { return (unsigned)__builtin_amdgcn_s_getreg((3 << 11) | 20) & 0xFu; }
#define XB_SPIN(cond, bar) do { unsigned _sp = 0; while (cond) { __builtin_amdgcn_s_sleep(1); \
    if ((++_sp & 255u) == 0u) { if (xb_ld(&(bar)[XB_TMO])) break; if (_sp > XB_SPIN_CAP) { atomicAdd(&(bar)[XB_TMO], 1u); break; } } } } while (0)

struct XcdBarrier {
    unsigned* bar; unsigned x;
    volatile LAS unsigned* st;
};

__device__ __forceinline__ XcdBarrier xcd_barrier_post(unsigned* bar, volatile LAS unsigned* st) {
    XcdBarrier b; b.bar = bar; b.x = xb_xcc_id(); b.st = st;
    if (threadIdx.x == 0) (void)xb_add(&bar[XB_XCNT(b.x)], 1u);
    return b;
}
__device__ __forceinline__ void xcd_barrier_complete(unsigned* bar, unsigned x, unsigned& nloc, unsigned& nx) {
    const unsigned G = gridDim.x * gridDim.y * gridDim.z;
    unsigned sum, cnt, mine, sp = 0u;
    for (;;) {
        sum = 0u; cnt = 0u; mine = 0u;
#pragma unroll
        for (unsigned j = 0; j < 16; ++j) { const unsigned c = xb_ld(&bar[XB_XCNT(j)]); sum += c; cnt += (c > 0u) ? 1u : 0u; mine = (j == x) ? c : mine; }
        if (sum == G) break;
        __builtin_amdgcn_s_sleep(1);
        if ((++sp & 255u) == 0u) { if (xb_ld(&bar[XB_TMO])) break; if (sp > XB_SPIN_CAP) { atomicAdd(&bar[XB_TMO], 1u); break; } }
    }
    nloc = mine > 0u ? mine : 1u; nx = cnt > 0u ? cnt : 1u;
}

__device__ __forceinline__ void xcd_barrier(const XcdBarrier& b) {
    asm volatile("s_waitcnt vmcnt(0)" ::: "memory");
    __syncthreads();
    if (threadIdx.x == 0) {
        unsigned* bar = b.bar;
        __builtin_amdgcn_s_waitcnt(0);
        unsigned nloc = b.st[0], nx = b.st[1];
        if (nloc == 0u) { xcd_barrier_complete(bar, b.x, nloc, nx); b.st[0] = nloc; b.st[1] = nx; }
        const unsigned old = xb_add(&bar[XB_XSUB(b.x)], 1u);
        const unsigned gen = old / nloc;
        if (old + 1u == (gen + 1u) * nloc) {
            __builtin_amdgcn_fence(__ATOMIC_RELEASE, "agent");
            asm volatile("s_waitcnt vmcnt(0)" ::: "memory");
            const unsigned og = xb_add(&bar[XB_TOP], 1u);
            const unsigned tg = og / nx;
            if (og + 1u == (tg + 1u) * nx) xb_add(&bar[XB_TOPGEN], 1u);
            else XB_SPIN(xb_ld(&bar[XB_TOPGEN]) == tg, bar);
            __builtin_amdgcn_fence(__ATOMIC_ACQUIRE, "agent");
            xb_add(&bar[XB_XGEN(b.x)], 1u);
            asm volatile("s_waitcnt vmcnt(0)" ::: "memory");
        } else {
            XB_SPIN(xb_ld(&bar[XB_XGEN(b.x)]) == gen, bar);
            __builtin_amdgcn_fence(__ATOMIC_ACQUIRE, "agent");
            asm volatile("s_waitcnt vmcnt(0)" ::: "memory");
        }
    }
    __syncthreads();
}

__global__ void __launch_bounds__(512, 2) fwd_kernel(Params p) {
    extern __shared__ __attribute__((aligned(16))) unsigned char lds_raw[];
    LAS unsigned char* lds = (LAS unsigned char*)lds_raw;
    cg::grid_group grid = cg::this_grid();
    constexpr int LDS_ST = 143360;
    { const int t0_ = otid(); if (t0_ < 2) ((LAS unsigned*)(lds + LDS_ST))[t0_] = 0u; __syncthreads();
      PP pp0 = (PP)__builtin_amdgcn_kernarg_segment_ptr(); (void)xcd_barrier_post((unsigned*)(pp0->ws + WS_CW), (volatile LAS unsigned*)(lds + LDS_ST)); }
#pragma unroll 1
    for (int ph = 0; ph < 15; ++ph) {
        if (ph == 8) continue;
        const int tid = otid(), lane = tid & 63, wave = __builtin_amdgcn_readfirstlane(tid >> 6), bid = obid(), nblk = ogrid();
        PP pp = (PP)__builtin_amdgcn_kernarg_segment_ptr();
        asm volatile("" : "+s"(pp));
        unsigned char* ws = pp->ws;
        bf16_t* XB = (bf16_t*)(ws + WS_XB); float* SS = (float*)(ws + WS_SS); bf16_t* BIG = (bf16_t*)(ws + WS_BIG);
        float* X = pp->out;
        if (ph == 4 || ph == 11) {
            const int layer = ph == 4 ? 0 : 1;
            const bf16_t* Bt = (const bf16_t*)(ws + (layer ? WS_WUP1 : WS_WUP0));
            pg8::Gemm g{XB, Bt, M, 6144, 1024, 1024}; pg8::StaticOrder S; S.init(M, 6144, nblk, bid);
            bf16_t* EGp = BIG + (size_t)M * 3072;
            pg8::EpiFfn E{BIG, EGp, EGp + (size_t)(M / 16) * 4 * 3072, SS, pp->in[26] + (size_t)layer * 3 * DFF, pp->in[27] + (size_t)layer * DFF};
            pg8::gemm_phase<pg8::EpiFfn, pg8::StaticOrder, true, true>(lds, g, S, E);
        } else if (ph == 7) {
            pg8::Gemm g{XB, (const bf16_t*)(ws + WS_WQKV), M, 3072, 1024, 1024}; pg8::StaticOrder S; S.init(M, 3072, nblk, bid);
            pg8::EpiQkv E{BIG, X, SS, pp->in[19], pp->in[22], (LAS float*)(lds + 131072), O_PK, O_PV, O_SK, O_SV, MP, QSCALE};
            pg8::gemm_phase<pg8::EpiQkv, pg8::StaticOrder, true, true>(lds, g, S, E);
        } else if (ph == 1) {
            const bf16_t* Bt; int N; const float* ss = SS;
            { Bt = (const bf16_t*)(ws + WS_WIN); N = 2048; }
            pg8::Gemm g{XB, Bt, M, N, 1024, 1024}; pg8::StaticOrder S; S.init(M, N, nblk, bid);
            pg8::EpiScaleBf16 E{BIG, N, ss};
#if !defined(NO_GS)
            pg8::gemm_phase<pg8::EpiScaleBf16, pg8::StaticOrder, true, true>(lds, g, S, E);
#endif
#if defined(PROBE_GS2)
            grid.sync(); pg8::gemm_phase<pg8::EpiScaleBf16, pg8::StaticOrder, true, true>(lds, g, S, E);
#endif
        } else if (ph == 3 || ph == 6 || ph == 10 || ph == 13) {
            const bf16_t* A; const bf16_t* Bt; int K, lda;
            if (ph == 3) { A = BIG + (size_t)M * 2048; lda = 1024; K = 1024; Bt = (const bf16_t*)(ws + WS_WOUT); }
            else if (ph == 6) { A = BIG; lda = 3072; K = 3072; Bt = (const bf16_t*)(ws + WS_WDN0); }
            else if (ph == 10) { A = BIG + (size_t)M * 3072; lda = 1024; K = 1024; Bt = (const bf16_t*)(ws + WS_WO); }
            else { A = BIG; lda = 3072; K = 3072; Bt = (const bf16_t*)(ws + WS_WDN1); }
            pg8::Gemm g{A, Bt, M, 1024, K, lda}; pg8::StaticOrder S; S.init(M, 1024, nblk, bid);
            pg8::EpiResid E{XB, SS};
#if !defined(NO_GR)
            pg8::gemm_phase<pg8::EpiResid, pg8::StaticOrder, true, true>(lds, g, S, E);
#endif
        }
#if !defined(NO_P0)
        else if (ph == 0) phase0(pp, lds, lane, wave);
#endif
#if !defined(NO_LRU)
        else if (ph == 2) {
#if defined(PROBE_L2)
            _Pragma("unroll 1") for (int rep = 0; rep < 2; ++rep) { if (rep) grid.sync(); lru_phase(pp, lds, tid, lane, wave); }
#else
            lru_phase(pp, lds, tid, lane, wave);
#endif
        }
#endif
#if !defined(NO_ACT)
        else if (ph == 5 || ph == 12) ffn_fix_phase(pp, ph == 5 ? 0 : 1, tid);
#endif
#if !defined(NO_HN)
        else if (ph == 8) headnorm_phase(pp, lane, wave);
#endif
#if !defined(NO_ATT)
        else if (ph == 9) {
#if defined(PROBE_A2)
            _Pragma("unroll 1") for (int rep = 0; rep < 2; ++rep) { if (rep) grid.sync(); attn_phase(pp, lds, tid, lane, wave); }
#else
            attn_phase(pp, lds, tid, lane, wave);
#endif
        }
#endif
#if !defined(NO_FIN)
        else if (ph == 14) final_phase(pp, lane, wave);
#endif
        if (ph == 0) grid.sync();
        else if (ph < 14) { XcdBarrier xb; xb.bar = (unsigned*)(ws + WS_CW); xb.x = xb_xcc_id(); xb.st = (volatile LAS unsigned*)(lds + LDS_ST); xcd_barrier(xb); }
    }
}

extern "C" void kernel_launch(void* const* d_in, const int* in_sizes, int n_in, void* d_out, int out_size, void* d_ws, size_t ws_size, hipStream_t stream) {
    static int grid = 0;
    if (grid == 0) {
        if (n_in != 30 || (size_t)out_size != O_END || ws_size < WS_END) { fprintf(stderr, "kernel_launch: unexpected shapes n_in %d out %d ws %zu (need %zu)\n", n_in, out_size, ws_size, (size_t)WS_END); grid = -1; return; }
        int dev = 0, cus = 0, per_cu = 0;
        hipGetDevice(&dev); hipDeviceGetAttribute(&cus, hipDeviceAttributeMultiprocessorCount, dev);
        if (hipFuncSetAttribute((const void*)fwd_kernel, hipFuncAttributeMaxDynamicSharedMemorySize, LDS_BYTES) != hipSuccess) { fprintf(stderr, "kernel_launch: hipFuncSetAttribute failed\n"); grid = -1; return; }
        if (hipOccupancyMaxActiveBlocksPerMultiprocessor(&per_cu, (const void*)fwd_kernel, 512, LDS_BYTES) != hipSuccess || per_cu < 1) { fprintf(stderr, "kernel_launch: occupancy query failed (%d)\n", per_cu); per_cu = 1; }
        (void)hipGetLastError();
        grid = cus * per_cu;
    }
    if (grid < 0) return;
    if (hipMemsetAsync((char*)d_ws + WS_CW, 0, CW_BYTES, stream) != hipSuccess) { fprintf(stderr, "kernel_launch: memset of the barrier words failed\n"); return; }
    Params p{};
    for (int i = 0; i < 30; ++i) p.in[i] = (const float*)d_in[i];
    p.out = (float*)d_out; p.ws = (unsigned char*)d_ws;
    void* args[] = {&p};
    hipError_t e = hipLaunchCooperativeKernel((const void*)fwd_kernel, dim3(grid), dim3(512), args, LDS_BYTES, stream);
    if (e != hipSuccess) fprintf(stderr, "cooperative launch failed: %s (grid %d)\n", hipGetErrorString(e), grid);
}
```

```cpp
#include <hip/hip_runtime.h>
#include <hip/hip_cooperative_groups.h>
#include <cstdio>
#include <cstdint>
namespace cg = cooperative_groups;

#define DI __device__ __forceinline__
#define LAS __attribute__((address_space(3)))

constexpr int D = 1024, NB = 32, T = 2048, DB = 16, DT = 16, PAST = 4096, NH = 8, HD = 128, DFF = 3072, NBLK = 16, BLK = 64;
constexpr int MP = NB * T, MS = DB * DT, M = MP + MS;
constexpr float EPS = 1e-6f;
constexpr float LOG2E = 1.4426950408889634f;
constexpr float QSCALE = 0.08838834764831845f * LOG2E;

constexpr size_t O_YP = 0, O_YS = O_YP + (size_t)MP * D, O_PH = O_YS + (size_t)MS * D, O_PC = O_PH + (size_t)NB * D, O_PF = O_PC + (size_t)NB * 3 * D,
                 O_PK = O_PF + (size_t)2 * NB * 2 * DFF, O_PV = O_PK + (size_t)MP * D, O_SH = O_PV + (size_t)MP * D, O_SC = O_SH + (size_t)DB * D,
                 O_SF = O_SC + (size_t)DB * 3 * D, O_SK = O_SF + (size_t)2 * DB * 2 * DFF, O_SV = O_SK + (size_t)MS * D, O_END = O_SV + (size_t)MS * D;
static_assert(O_END == 202899456ull, "output size");

constexpr size_t MiB = 1u << 20;
constexpr size_t WS_WIN = 0, WS_WOUT = 4 * MiB, WS_WUP0 = 6 * MiB, WS_WUP1 = 18 * MiB, WS_WDN0 = 30 * MiB, WS_WDN1 = 36 * MiB, WS_WQKV = 42 * MiB, WS_WO = 48 * MiB,
                 WS_WRT = 50 * MiB, WS_WIT = 50 * MiB + 128 * 1024, WS_SS = 52 * MiB, WS_CW = 57 * MiB  , CW_BYTES = 16 * 1024, WS_XB = 58 * MiB, WS_BIG = 187 * MiB, WS_END = WS_BIG + (size_t)M * 6144 * 2;
static_assert(WS_XB + (size_t)M * D * 2 <= WS_BIG && WS_SS + (size_t)M * 16 * 4 <= WS_XB && WS_END <= 1024 * MiB, "ws map");

constexpr int LDS_BYTES = 147456;

typedef unsigned short bf16_t;
typedef float f32x2 __attribute__((ext_vector_type(2)));
typedef float f32x4 __attribute__((ext_vector_type(4)));
typedef float f32x16 __attribute__((ext_vector_type(16)));
typedef short bf16x8 __attribute__((ext_vector_type(8)));
typedef short s16x4 __attribute__((ext_vector_type(4)));
typedef unsigned u32x4 __attribute__((ext_vector_type(4)));
typedef unsigned u32x2 __attribute__((ext_vector_type(2)));
typedef __bf16 bf16x2_t __attribute__((ext_vector_type(2)));

DI unsigned pk2(float lo, float hi) { f32x2 v = {lo, hi}; bf16x2_t b = __builtin_convertvector(v, bf16x2_t); return __builtin_bit_cast(unsigned, b); }
DI float bflo(unsigned u) { return __uint_as_float(u << 16); }
DI float bfhi(unsigned u) { return __uint_as_float(u & 0xffff0000u); }
DI void unpack8(const u32x4 v, float (&f)[8]) { f[0] = bflo(v.x); f[1] = bfhi(v.x); f[2] = bflo(v.y); f[3] = bfhi(v.y); f[4] = bflo(v.z); f[5] = bfhi(v.z); f[6] = bflo(v.w); f[7] = bfhi(v.w); }
DI u32x4 pack8(const float (&f)[8]) { u32x4 w; w.x = pk2(f[0], f[1]); w.y = pk2(f[2], f[3]); w.z = pk2(f[4], f[5]); w.w = pk2(f[6], f[7]); return w; }
DI float fexp2(float x) { return __builtin_amdgcn_exp2f(x); }
DI float frcp(float x) { return __builtin_amdgcn_rcpf(x); }
DI float sigmoidf_(float x) { return frcp(1.0f + fexp2(-x * LOG2E)); }
DI float gelu_tanh(float x) { const float u = 0.7978845608028654f * (x + 0.044715f * x * x * x); return x * frcp(1.0f + fexp2(-2.0f * LOG2E * u)); }
DI float wave_sum(float v) {
#pragma unroll
    for (int o = 1; o < 64; o <<= 1) v += __shfl_xor(v, o);
    return v;
}
namespace pg8 {
#define PG8_LAS __attribute__((address_space(3)))
typedef unsigned short bf16_t;
typedef short bf16x8 __attribute__((ext_vector_type(8)));
typedef float f32x4 __attribute__((ext_vector_type(4)));
typedef unsigned u32x4 __attribute__((ext_vector_type(4)));
constexpr int BM = 256, BK = 64, HALF = 128, HTB = HALF * BK * 2  , STAGE_BYTES = 8 * HTB, NXCD = 8, WGM = 8;

__host__ __device__ __forceinline__ int lds_byte(int r, int c) { const int st = (r >> 4) * 2 + (c >> 5), rr = r & 15, cc = c & 31, ob = rr * 64 + cc * 2; return st * 1024 + (ob ^ (((ob >> 9) & 1) << 5)); }
__host__ __device__ __forceinline__ void stage_rc(int b, int& R, int& C) { const int st = b / 1024, sb = b % 1024, swz = sb ^ (((sb >> 9) & 1) << 5); R = (st >> 1) * 16 + swz / 64; C = (st & 1) * 32 + (swz % 64) / 2; }
__host__ __device__ __forceinline__ int perm32(int rho) { const int n = rho >> 4, i = rho & 15; return 8 * (i >> 2) + 4 * n + (i & 3); }

struct Unit { int pm, pn; };
struct Gemm { const bf16_t* A; const bf16_t* Bt; int M, N, K, lda; };

struct StaticOrder {
    int nM, nN, nwg, G, c;
    __host__ __device__ void init(int M, int N, int G_, int c_) { nM = M / BM; nN = N / BM; nwg = nM * nN; G = G_; c = c_; }
    __host__ __device__ bool next(int i, Unit& u) const {
        const long L = (long)i * G + c; if (L >= nwg) return false;
        int wgid = (int)L; { const int q = nwg / NXCD, r = nwg % NXCD, xcd = wgid % NXCD, off = wgid / NXCD; wgid = (xcd < r ? xcd * (q + 1) : r * (q + 1) + (xcd - r) * q) + off; }
        const int nig = WGM * nN, gid = wgid / nig, fm = gid * WGM, gsz = (nM - fm) < WGM ? (nM - fm) : WGM;
        u.pm = fm + ((wgid % nig) % gsz); u.pn = (wgid % nig) / gsz; return true;
    }
    __device__ __forceinline__ void a_ready(const Unit&) const {}
    __device__ __forceinline__ void done(const Unit&) const {}
};
__device__ __forceinline__ unsigned cvt_pk_bf16(float lo, float hi) { unsigned r; asm volatile("v_cvt_pk_bf16_f32 %0, %1, %2" : "=v"(r) : "v"(lo), "v"(hi)); return r; }
DI float row_rstd(const float* ss, int row) {
    const f32x4* p = (const f32x4*)(ss + (size_t)row * 16);
    const f32x4 a = p[0], b = p[1], c = p[2], d = p[3];
    const float s = ((a[0] + a[1]) + (a[2] + a[3])) + ((b[0] + b[1]) + (b[2] + b[3])) + ((c[0] + c[1]) + (c[2] + c[3])) + ((d[0] + d[1]) + (d[2] + d[3]));
    return __builtin_amdgcn_rsqf(s * (1.0f / 1024.0f) + 1e-6f);
}
struct EpiScaleBf16 {
    static constexpr bool PERM = true, AFTER_DRAIN = false;
    bf16_t* O; int ldc; const float* ss;
    DI void operator()(const f32x4 (&acc)[2][2][4][2], const Unit& u, int wr, int wc, int fr, int fq) const {
        const int row0 = u.pm * BM + wr * 64 + fr, col0 = u.pn * BM + wc * 32 + 8 * fq;
#pragma unroll
        for (int ai = 0; ai < 2; ++ai)
#pragma unroll
            for (int m = 0; m < 4; ++m) {
                const int row = row0 + ai * HALF + m * 16;
                const float sc = ss ? row_rstd(ss, row) : 1.0f;
                bf16_t* rowp = O + (size_t)row * ldc + col0;
#pragma unroll
                for (int bj = 0; bj < 2; ++bj) {
                    const f32x4 v0 = acc[ai][bj][m][0] * sc, v1 = acc[ai][bj][m][1] * sc;
                    u32x4 w; w.x = cvt_pk_bf16(v0[0], v0[1]); w.y = cvt_pk_bf16(v0[2], v0[3]); w.z = cvt_pk_bf16(v1[0], v1[1]); w.w = cvt_pk_bf16(v1[2], v1[3]);
                    *(u32x4*)(rowp + bj * HALF) = w;
                }
                if (m & 1) asm volatile("" ::: "memory");
            }
    }
};
struct EpiResid {
    static constexpr bool PERM = true, AFTER_DRAIN = false;
    bf16_t* XB; float* ss;
    DI void operator()(const f32x4 (&acc)[2][2][4][2], const Unit& u, int wr, int wc, int fr, int fq) const {
        const int row0 = u.pm * BM + wr * 64 + fr, col0 = u.pn * BM + wc * 32 + 8 * fq;
#pragma unroll
        for (int ai = 0; ai < 2; ++ai)
#pragma unroll
            for (int m = 0; m < 4; ++m) {
                const int row = row0 + ai * HALF + m * 16;
                bf16_t* xb = XB + (size_t)row * 1024 + col0;
                float sq = 0.f;
#pragma unroll
                for (int bj = 0; bj < 2; ++bj) {
                    const u32x4 r = *(const u32x4*)(xb + bj * HALF);
                    const f32x4 r0 = {__uint_as_float(r.x << 16), __uint_as_float(r.x & 0xffff0000u), __uint_as_float(r.y << 16), __uint_as_float(r.y & 0xffff0000u)};
                    const f32x4 r1 = {__uint_as_float(r.z << 16), __uint_as_float(r.z & 0xffff0000u), __uint_as_float(r.w << 16), __uint_as_float(r.w & 0xffff0000u)};
                    const f32x4 v0 = acc[ai][bj][m][0] + r0, v1 = acc[ai][bj][m][1] + r1;
                    u32x4 w; w.x = cvt_pk_bf16(v0[0], v0[1]); w.y = cvt_pk_bf16(v0[2], v0[3]); w.z = cvt_pk_bf16(v1[0], v1[1]); w.w = cvt_pk_bf16(v1[2], v1[3]);
                    *(u32x4*)(xb + bj * HALF) = w;
                    sq += (v0[0] * v0[0] + v0[1] * v0[1]) + (v0[2] * v0[2] + v0[3] * v0[3]) + (v1[0] * v1[0] + v1[1] * v1[1]) + (v1[2] * v1[2] + v1[3] * v1[3]);
                }
                sq += __shfl_xor(sq, 16); sq += __shfl_xor(sq, 32);
                if (fq == 0) ss[(size_t)row * 16 + u.pn * 4 + wc] = sq;
                if (m & 1) asm volatile("" ::: "memory");
            }
    }
};
struct EpiFfn {
    static constexpr bool PERM = true, AFTER_DRAIN = false;
    bf16_t* H; bf16_t* EG; bf16_t* EU; const float* ss; const float* cw; const float* cb;
    DI void operator()(const f32x4 (&acc)[2][2][4][2], const Unit& u, int wr, int wc, int fr, int fq) const {
        const int row0 = u.pm * BM + wr * 64 + fr, hc = u.pn * HALF + wc * 32 + 8 * fq;
        float w0[8], w1[8], w2[8], bb[8];
        { const f32x4 a0 = *(const f32x4*)(cw + hc), a1 = *(const f32x4*)(cw + hc + 4), b0 = *(const f32x4*)(cw + 3072 + hc), b1 = *(const f32x4*)(cw + 3072 + hc + 4),
                      c0 = *(const f32x4*)(cw + 6144 + hc), c1 = *(const f32x4*)(cw + 6144 + hc + 4), d0 = *(const f32x4*)(cb + hc), d1 = *(const f32x4*)(cb + hc + 4);
#pragma unroll
          for (int i = 0; i < 4; ++i) { w0[i] = a0[i]; w0[i + 4] = a1[i]; w1[i] = b0[i]; w1[i + 4] = b1[i]; w2[i] = c0[i]; w2[i + 4] = c1[i]; bb[i] = d0[i]; bb[i + 4] = d1[i]; } }
#pragma unroll
        for (int ai = 0; ai < 2; ++ai)
#pragma unroll
            for (int m = 0; m < 4; ++m) {
                const int row = row0 + ai * HALF + m * 16;
                const float sc = row_rstd(ss, row);
                float g[8], uu[8];
#pragma unroll
                for (int i = 0; i < 4; ++i) { g[i] = acc[ai][0][m][0][i] * sc; g[i + 4] = acc[ai][0][m][1][i] * sc; uu[i] = acc[ai][1][m][0][i] * sc; uu[i + 4] = acc[ai][1][m][1][i] * sc; }
                u32x4 hw; unsigned hp[4];
#pragma unroll
                for (int i = 0; i < 8; i += 2) {
                    const float pa1 = __shfl_up(g[i], 1, 16), pa2 = __shfl_up(g[i], 2, 16), pb1 = __shfl_up(g[i + 1], 1, 16), pb2 = __shfl_up(g[i + 1], 2, 16);
                    const float ca = bb[i] + w0[i] * pa2 + w1[i] * pa1 + w2[i] * g[i], cb2 = bb[i + 1] + w0[i + 1] * pb2 + w1[i + 1] * pb1 + w2[i + 1] * g[i + 1];
                    const float ua = 0.7978845608028654f * (ca + 0.044715f * ca * ca * ca), ub = 0.7978845608028654f * (cb2 + 0.044715f * cb2 * cb2 * cb2);
                    const float ha = ca * __builtin_amdgcn_rcpf(1.0f + __builtin_amdgcn_exp2f(-2.8853900817779268f * ua)) * uu[i];
                    const float hb = cb2 * __builtin_amdgcn_rcpf(1.0f + __builtin_amdgcn_exp2f(-2.8853900817779268f * ub)) * uu[i + 1];
                    hp[i >> 1] = cvt_pk_bf16(ha, hb);
                }
                hw.x = hp[0]; hw.y = hp[1]; hw.z = hp[2]; hw.w = hp[3];
                if (fr >= 2) *(u32x4*)(H + (size_t)row * 3072 + hc) = hw;
                if (fr >= 14 || fr < 2) {
                    u32x4 gw; gw.x = cvt_pk_bf16(g[0], g[1]); gw.y = cvt_pk_bf16(g[2], g[3]); gw.z = cvt_pk_bf16(g[4], g[5]); gw.w = cvt_pk_bf16(g[6], g[7]);
                    *(u32x4*)(EG + ((size_t)(row >> 4) * 4 + ((fr + 2) & 3)) * 3072 + hc) = gw;
                    if (fr < 2) { u32x4 uw; uw.x = cvt_pk_bf16(uu[0], uu[1]); uw.y = cvt_pk_bf16(uu[2], uu[3]); uw.z = cvt_pk_bf16(uu[4], uu[5]); uw.w = cvt_pk_bf16(uu[6], uu[7]);
                        *(u32x4*)(EU + ((size_t)(row >> 4) * 2 + fr) * 3072 + hc) = uw; }
                }
                asm volatile("" ::: "memory");
            }
    }
};

struct EpiQkv {
    static constexpr bool PERM = true, AFTER_DRAIN = false;
    bf16_t* O; float* outp; const float* ss; const float* kn; const float* qn; PG8_LAS float* part;
    size_t o_pk, o_pv, o_sk, o_sv; int mp; float qscale;
    DI void operator()(const f32x4 (&acc)[2][2][4][2], const Unit& u, int wr, int wc, int fr, int fq) const {
        const int kind = u.pn >> 2;
        const int row0 = u.pm * BM + wr * 64 + fr, col0 = u.pn * BM + wc * 32 + 8 * fq, hcol = (u.pn & 3) * BM + wc * 32 + 8 * fq;
        if (kind == 1) {
#pragma unroll
            for (int ai = 0; ai < 2; ++ai)
#pragma unroll
                for (int m = 0; m < 4; ++m) {
                    const int row = row0 + ai * HALF + m * 16;
                    const float sc = row_rstd(ss, row);
                    const size_t ob = (row < mp ? o_pv + (size_t)row * 1024 : o_sv + (size_t)(row - mp) * 1024) + hcol;
#pragma unroll
                    for (int bj = 0; bj < 2; ++bj) {
                        const f32x4 v0 = acc[ai][bj][m][0] * sc, v1 = acc[ai][bj][m][1] * sc;
                        *(f32x4*)(outp + ob + bj * HALF) = v0; *(f32x4*)(outp + ob + bj * HALF + 4) = v1;
                        u32x4 w; w.x = cvt_pk_bf16(v0[0], v0[1]); w.y = cvt_pk_bf16(v0[2], v0[3]); w.z = cvt_pk_bf16(v1[0], v1[1]); w.w = cvt_pk_bf16(v1[2], v1[3]);
                        *(u32x4*)(O + (size_t)row * 3072 + col0 + bj * HALF) = w;
                    }
                    if (m & 1) asm volatile("" ::: "memory");
                }
            return;
        }
        float scr[2][4];
#pragma unroll
        for (int ai = 0; ai < 2; ++ai)
#pragma unroll
            for (int m = 0; m < 4; ++m) {
                const int rl = ai * HALF + wr * 64 + m * 16 + fr;
                const float sc = row_rstd(ss, u.pm * BM + rl); scr[ai][m] = sc;
#pragma unroll
                for (int bj = 0; bj < 2; ++bj) {
                    const f32x4 v0 = acc[ai][bj][m][0] * sc, v1 = acc[ai][bj][m][1] * sc;
                    float s = (v0[0] * v0[0] + v0[1] * v0[1]) + (v0[2] * v0[2] + v0[3] * v0[3]) + (v1[0] * v1[0] + v1[1] * v1[1]) + (v1[2] * v1[2] + v1[3] * v1[3]);
                    s += __shfl_xor(s, 16); s += __shfl_xor(s, 32);
                    if (fq == 0) part[(rl * 2 + bj) * 4 + wc] = s;
                }
            }
        asm volatile("s_waitcnt lgkmcnt(0)" ::: "memory"); __builtin_amdgcn_s_barrier(); asm volatile("" ::: "memory");
        const float* gp = (kind == 0 ? kn : qn) + wc * 32 + 8 * fq;
        const float gm = kind == 0 ? 1.0f : qscale;
        const f32x4 g0 = *(const f32x4*)gp * gm, g1 = *(const f32x4*)(gp + 4) * gm;
#pragma unroll
        for (int ai = 0; ai < 2; ++ai)
#pragma unroll
            for (int m = 0; m < 4; ++m) {
                const int rl = ai * HALF + wr * 64 + m * 16 + fr, row = u.pm * BM + rl;
                const size_t ob = (row < mp ? o_pk + (size_t)row * 1024 : o_sk + (size_t)(row - mp) * 1024) + hcol;
#pragma unroll
                for (int bj = 0; bj < 2; ++bj) {
                    const f32x4 ps = *(const PG8_LAS f32x4*)(part + (rl * 2 + bj) * 4);
                    const float rs = __builtin_amdgcn_rsqf(((ps[0] + ps[1]) + (ps[2] + ps[3])) * (1.0f / 128.0f) + 1e-6f) * scr[ai][m];
                    const f32x4 v0 = acc[ai][bj][m][0] * rs * g0, v1 = acc[ai][bj][m][1] * rs * g1;
                    if (kind == 0) { *(f32x4*)(outp + ob + bj * HALF) = v0; *(f32x4*)(outp + ob + bj * HALF + 4) = v1; }
                    u32x4 w; w.x = cvt_pk_bf16(v0[0], v0[1]); w.y = cvt_pk_bf16(v0[2], v0[3]); w.z = cvt_pk_bf16(v1[0], v1[1]); w.w = cvt_pk_bf16(v1[2], v1[3]);
                    *(u32x4*)(O + (size_t)row * 3072 + col0 + bj * HALF) = w;
                }
                if (m & 1) asm volatile("" ::: "memory");
            }
    }
};
template <class Epi, class Sched, bool ALIGN_EPI = false, bool SP2 = false>
__device__ __forceinline__ void gemm_phase(PG8_LAS unsigned char* lds, const Gemm g, const Sched& S, const Epi& E) {
    int tid = threadIdx.x; asm volatile("" : "+v"(tid)); const int wid = __builtin_amdgcn_readfirstlane(tid >> 6), lane = tid & 63, wr = wid >> 2, wc = wid & 3, fr = lane & 15, fq = lane >> 4;
    const int K = g.K, nt = K / BK;
    unsigned voffA[2], voffB[2];
#pragma unroll
    for (int i = 0; i < 2; ++i) { int R, C; stage_rc(tid * 16 + i * 8192, R, C); const int Rb = Epi::PERM ? ((R & ~31) + perm32(R & 31)) : R;
        voffA[i] = (unsigned)(R * g.lda + C) * 2u; voffB[i] = (unsigned)(Rb * K + C) * 2u; }
    const size_t kstep = (size_t)(BK * 2);
    const size_t hstep = (size_t)HALF * K * 2;
    const size_t tstep = 2 * hstep; const size_t hstepA = (size_t)HALF * g.lda * 2, tstepA = 2 * hstepA;
    const unsigned ldsw = (unsigned)wid * 1024u;
    const int aoff = lds_byte(wr * 64 + fr, fq * 8), boff = lds_byte(wc * 32 + fr, fq * 8);
#define PG8_SA(b, h) (((b) * 2 + (h)) * HTB)
#define PG8_SB(b, h) ((4 + (b) * 2 + (h)) * HTB)
#define PG8_STAGE(bufoff, gbase, voff) do { _Pragma("unroll") for (int _i = 0; _i < 2; ++_i) \
        __builtin_amdgcn_global_load_lds((const unsigned*)((const char*)(gbase) + (voff)[_i]), (PG8_LAS unsigned*)(lds + (bufoff) + ldsw + _i * 8192), 16, 0, 0); } while (0)
#define PG8_LDA(dst, b, h) do { _Pragma("unroll") for (int m = 0; m < 4; ++m) _Pragma("unroll") for (int k = 0; k < 2; ++k) dst[m][k] = *(const PG8_LAS bf16x8*)(lds + PG8_SA(b, h) + aoff + m * 2048 + k * 1024); } while (0)
#define PG8_LDB(dst, b, h) do { _Pragma("unroll") for (int n = 0; n < 2; ++n) _Pragma("unroll") for (int k = 0; k < 2; ++k) dst[n][k] = *(const PG8_LAS bf16x8*)(lds + PG8_SB(b, h) + boff + n * 2048 + k * 1024); } while (0)
#define PG8_MMA(ai, bj, At, Bt) do { __builtin_amdgcn_s_setprio(1); _Pragma("unroll") for (int m = 0; m < 4; ++m) _Pragma("unroll") for (int n = 0; n < 2; ++n) _Pragma("unroll") for (int k = 0; k < 2; ++k) \
        acc[ai][bj][m][n] = __builtin_amdgcn_mfma_f32_16x16x32_bf16(Bt[n][k], At[m][k], acc[ai][bj][m][n], 0, 0, 0); __builtin_amdgcn_s_setprio(0); } while (0)
#define PG8_WAIT_V(n) asm volatile("s_waitcnt vmcnt(" #n ")" ::: "memory")
#define PG8_WAIT_L(n) asm volatile("s_waitcnt lgkmcnt(" #n ")" ::: "memory")
#define PG8_BAR __builtin_amdgcn_s_barrier()
#define PG8_SCHED __builtin_amdgcn_sched_barrier(0)
    Unit cur, nxt; int ui = 0;
    if (!S.next(0, cur)) return;
    f32x4 acc[2][2][4][2];
#pragma unroll
    for (int a = 0; a < 2; ++a)
#pragma unroll
        for (int b = 0; b < 2; ++b)
#pragma unroll
            for (int m = 0; m < 4; ++m)
#pragma unroll
                for (int n = 0; n < 2; ++n) acc[a][b][m][n] = (f32x4){0.f, 0.f, 0.f, 0.f};
    bf16x8 At[4][2], B0[2][2], B1[2][2];
    const char* cA = (const char*)g.A + (size_t)cur.pm * tstepA; const char* cB = (const char*)g.Bt + (size_t)cur.pn * tstep;
    S.a_ready(cur);
    if constexpr (SP2) {
        PG8_STAGE(PG8_SB(0, 0), cB, voffB); PG8_STAGE(PG8_SB(0, 1), cB + hstep, voffB); PG8_STAGE(PG8_SA(0, 0), cA, voffA); PG8_STAGE(PG8_SA(0, 1), cA + hstepA, voffA);
        if (wr == 1) PG8_BAR;
        PG8_WAIT_V(2); PG8_BAR;
        PG8_STAGE(PG8_SB(1, 0), cB + kstep, voffB); PG8_STAGE(PG8_SA(1, 0), cA + kstep, voffA); PG8_STAGE(PG8_SB(1, 1), cB + hstep + kstep, voffB);
        PG8_WAIT_V(6); PG8_BAR;
    } else {
        PG8_STAGE(PG8_SB(0, 0), cB, voffB); PG8_STAGE(PG8_SA(0, 0), cA, voffA); PG8_STAGE(PG8_SB(0, 1), cB + hstep, voffB); PG8_STAGE(PG8_SA(0, 1), cA + hstepA, voffA);
        if (wr == 1) PG8_BAR;
        PG8_WAIT_V(4); PG8_BAR;
        PG8_STAGE(PG8_SB(1, 0), cB + kstep, voffB); PG8_STAGE(PG8_SA(1, 0), cA + kstep, voffA); PG8_STAGE(PG8_SB(1, 1), cB + hstep + kstep, voffB);
        PG8_WAIT_V(6); PG8_BAR;
    }
    for (;;) {
        const bool has_next = S.next(ui + 1, nxt);
        const char* nA = has_next ? (const char*)g.A + (size_t)nxt.pm * tstepA : cA; const char* nB = has_next ? (const char*)g.Bt + (size_t)nxt.pn * tstep : cB;
        for (int t = 0; t < nt; t += 2) {
            const bool last = (t == nt - 2);
            const char* a1 = cA + (size_t)(t + 1) * kstep;
            const char* a2 = last ? nA : cA + (size_t)(t + 2) * kstep; const char* b2 = last ? nB : cB + (size_t)(t + 2) * kstep;
            const char* a3 = a2 + kstep; const char* b3 = b2 + kstep;
            if (last && has_next) S.a_ready(nxt);
            if constexpr (SP2) {
            PG8_LDB(B0, 0, 0); PG8_LDB(B1, 0, 1); PG8_SCHED; PG8_LDA(At, 0, 0); PG8_STAGE(PG8_SA(1, 1), a1 + hstepA, voffA);
            PG8_WAIT_V(8); PG8_WAIT_L(0); PG8_BAR; PG8_MMA(0, 0, At, B0); PG8_MMA(0, 1, At, B1); PG8_BAR; PG8_SCHED;
            PG8_LDA(At, 0, 1); PG8_STAGE(PG8_SB(0, 0), b2, voffB); PG8_STAGE(PG8_SB(0, 1), b2 + hstep, voffB); PG8_STAGE(PG8_SA(0, 0), a2, voffA);
            PG8_WAIT_V(8); PG8_WAIT_L(0); PG8_BAR; PG8_MMA(1, 0, At, B0); PG8_MMA(1, 1, At, B1); PG8_BAR; PG8_SCHED;
            PG8_LDB(B0, 1, 0); PG8_LDB(B1, 1, 1); PG8_SCHED; PG8_LDA(At, 1, 0); PG8_STAGE(PG8_SA(0, 1), a2 + hstepA, voffA);
            PG8_WAIT_V(8); PG8_WAIT_L(0); PG8_BAR; PG8_MMA(0, 0, At, B0); PG8_MMA(0, 1, At, B1); PG8_BAR; PG8_SCHED;
            PG8_LDA(At, 1, 1); PG8_STAGE(PG8_SB(1, 0), b3, voffB); PG8_STAGE(PG8_SB(1, 1), b3 + hstep, voffB); PG8_STAGE(PG8_SA(1, 0), a3, voffA);
            PG8_WAIT_V(8); PG8_WAIT_L(0); PG8_BAR; PG8_MMA(1, 0, At, B0); PG8_MMA(1, 1, At, B1); PG8_BAR; PG8_SCHED;
            } else {
            PG8_LDB(B0, 0, 0); PG8_SCHED; PG8_LDA(At, 0, 0); PG8_STAGE(PG8_SA(1, 1), a1 + hstepA, voffA);
            PG8_WAIT_L(8); PG8_BAR; PG8_WAIT_L(0); PG8_MMA(0, 0, At, B0); PG8_BAR; PG8_SCHED;
            PG8_LDB(B1, 0, 1); PG8_STAGE(PG8_SB(0, 0), b2, voffB);
            PG8_BAR; PG8_WAIT_L(0); PG8_MMA(0, 1, At, B1); PG8_BAR;
            PG8_LDA(At, 0, 1); PG8_STAGE(PG8_SA(0, 0), a2, voffA);
            PG8_BAR; PG8_WAIT_L(0); PG8_MMA(1, 0, At, B0); PG8_BAR; PG8_SCHED;
            PG8_STAGE(PG8_SB(0, 1), b2 + hstep, voffB);
            PG8_WAIT_V(6); PG8_BAR; PG8_MMA(1, 1, At, B1); PG8_BAR;
            PG8_LDB(B0, 1, 0); PG8_SCHED; PG8_LDA(At, 1, 0); PG8_STAGE(PG8_SA(0, 1), a2 + hstepA, voffA);
            PG8_WAIT_L(8); PG8_BAR; PG8_WAIT_L(0); PG8_MMA(0, 0, At, B0); PG8_BAR; PG8_SCHED;
            PG8_LDB(B1, 1, 1); PG8_STAGE(PG8_SB(1, 0), b3, voffB);
            PG8_BAR; PG8_WAIT_L(0); PG8_MMA(0, 1, At, B1); PG8_BAR;
            PG8_LDA(At, 1, 1); PG8_STAGE(PG8_SA(1, 0), a3, voffA);
            PG8_BAR; PG8_WAIT_L(0); PG8_MMA(1, 0, At, B0); PG8_BAR; PG8_SCHED;
            PG8_STAGE(PG8_SB(1, 1), b3 + hstep, voffB);
            PG8_WAIT_V(6); PG8_BAR; PG8_MMA(1, 1, At, B1); PG8_BAR;
            }
        }
        if constexpr (ALIGN_EPI) { if (wr == 0) PG8_BAR; }
        if constexpr (!Epi::AFTER_DRAIN) { E(acc, cur, wr, wc, fr, fq); S.done(cur); }
        if (!has_next) break;
#pragma unroll
        for (int a = 0; a < 2; ++a)
#pragma unroll
            for (int b = 0; b < 2; ++b)
#pragma unroll
                for (int m = 0; m < 4; ++m)
#pragma unroll
                    for (int n = 0; n < 2; ++n) acc[a][b][m][n] = (f32x4){0.f, 0.f, 0.f, 0.f};
        cur = nxt; cA = nA; cB = nB; ++ui;
        if constexpr (ALIGN_EPI) { if (wr == 1) PG8_BAR; }
    }
    PG8_WAIT_V(0);
    if constexpr (!ALIGN_EPI) { if (wr == 0) PG8_BAR; }
    PG8_BAR;
    if constexpr (Epi::AFTER_DRAIN) { E.fused(acc, cur, wr, wc, fr, fq, lds, wid, lane); S.done(cur); }
#undef PG8_SA
#undef PG8_SB
#undef PG8_STAGE
#undef PG8_LDA
#undef PG8_LDB
#undef PG8_MMA
#undef PG8_WAIT_V
#undef PG8_WAIT_L
#undef PG8_BAR
#undef PG8_SCHED
}
}

struct Params { const float* in[30]; float* out; unsigned char* ws; };
typedef const __attribute__((address_space(4))) Params* PP;

DI int otid() { int t = threadIdx.x; asm volatile("" : "+v"(t)); return t; }
DI int obid() { int t = blockIdx.x; asm volatile("" : "+s"(t)); return t; }
DI int ogrid() { int t = gridDim.x; asm volatile("" : "+s"(t)); return t; }
#define LDS_WAIT() asm volatile("s_waitcnt lgkmcnt(0)" ::: "memory")
#define MFMA16(a, b, c) __builtin_amdgcn_mfma_f32_16x16x32_bf16((a), (b), (c), 0, 0, 0)
#define MFMA32(a, b, c) __builtin_amdgcn_mfma_f32_32x32x16_bf16((a), (b), (c), 0, 0, 0)

template <bool FFN_PERM = false>
DI void p0_transpose_item(const float* W, const float* gk, int K, int N, bf16_t* WT, int row_off, LAS float* scr, int item, int lane) {
    const int nblk = N / 32, kb = item / nblk, nb = item % nblk, k0 = 64 * kb, n0 = 32 * nb;
    if (FFN_PERM) { const int j = n0 < 3072 ? n0 : n0 - 3072; row_off = (j >> 7) * 256 + (n0 < 3072 ? 0 : 128) + (j & 127) - n0; }
#pragma unroll 8
    for (int i = 0; i < 32; ++i) { const int kk = 2 * i + (lane >> 5); const float gv = gk ? gk[k0 + kk] : 1.0f; scr[kk * 33 + (lane & 31)] = __builtin_nontemporal_load(&W[(size_t)(k0 + kk) * N + n0 + (lane & 31)]) * gv; }
    LDS_WAIT(); asm volatile("" ::: "memory");
    const int c = lane & 7;
#pragma unroll
    for (int j = 0; j < 4; ++j) { const int n = (lane >> 3) + 8 * j; const LAS float* s = scr + (8 * c) * 33 + n;
        u32x4 o; o.x = pk2(s[0 * 33], s[1 * 33]); o.y = pk2(s[2 * 33], s[3 * 33]); o.z = pk2(s[4 * 33], s[5 * 33]); o.w = pk2(s[6 * 33], s[7 * 33]);
        *(u32x4*)(WT + (size_t)(row_off + n0 + n) * K + k0 + 8 * c) = o; }
    LDS_WAIT(); asm volatile("" ::: "memory");
}
DI void phase0(PP pp, LAS unsigned char* lds, int lane, int wave) {
    LAS float* scr = (LAS float*)(lds + wave * 16384);
    const int gw = obid() * 8 + wave, NGW = ogrid() * 8;
    unsigned char* ws = pp->ws;
    for (int it = gw; it < 12864; it += NGW) {
        int r = it;
        if (r < 1024) { p0_transpose_item(pp->in[8], pp->in[7], 1024, 2048, (bf16_t*)(ws + WS_WIN), 0, scr, r, lane); continue; } r -= 1024;
        if (r < 512) { p0_transpose_item(pp->in[16], nullptr, 1024, 1024, (bf16_t*)(ws + WS_WOUT), 0, scr, r, lane); continue; } r -= 512;
        if (r < 3072) { p0_transpose_item<true>(pp->in[25], pp->in[24], 1024, 6144, (bf16_t*)(ws + WS_WUP0), 0, scr, r, lane); continue; } r -= 3072;
        if (r < 3072) { p0_transpose_item<true>(pp->in[25] + (size_t)1024 * 6144, pp->in[24] + 1024, 1024, 6144, (bf16_t*)(ws + WS_WUP1), 0, scr, r, lane); continue; } r -= 3072;
        if (r < 1536) { p0_transpose_item(pp->in[28], nullptr, 3072, 1024, (bf16_t*)(ws + WS_WDN0), 0, scr, r, lane); continue; } r -= 1536;
        if (r < 1536) { p0_transpose_item(pp->in[28] + (size_t)3072 * 1024, nullptr, 3072, 1024, (bf16_t*)(ws + WS_WDN1), 0, scr, r, lane); continue; } r -= 1536;
        if (r < 1024) { p0_transpose_item(pp->in[18], pp->in[17], 1024, 2048, (bf16_t*)(ws + WS_WQKV), 0, scr, r, lane); continue; } r -= 1024;
        if (r < 512) { p0_transpose_item(pp->in[21], pp->in[20], 1024, 1024, (bf16_t*)(ws + WS_WQKV), 2048, scr, r, lane); continue; } r -= 512;
        if (r < 512) { p0_transpose_item(pp->in[23], nullptr, 1024, 1024, (bf16_t*)(ws + WS_WO), 0, scr, r, lane); continue; } r -= 512;
        if (r < 32) { const int blk = r >> 1; p0_transpose_item(pp->in[11] + blk * 4096, nullptr, 64, 64, (bf16_t*)(ws + WS_WRT) + blk * 4096, 0, scr, r & 1, lane); continue; } r -= 32;
        { const int blk = r >> 1; p0_transpose_item(pp->in[13] + blk * 4096, nullptr, 64, 64, (bf16_t*)(ws + WS_WIT) + blk * 4096, 0, scr, r & 1, lane); }
    }
    bf16_t* XB = (bf16_t*)(ws + WS_XB);
    float* SSp = (float*)(ws + WS_SS);
    for (int m4 = gw * 4; m4 < M; m4 += NGW * 4) {
        const float* xbase = m4 < MP ? pp->in[0] + (size_t)m4 * D : pp->in[1] + (size_t)(m4 - MP) * D;
        f32x4 v[4][4];
#pragma unroll
        for (int r = 0; r < 4; ++r)
#pragma unroll
            for (int j = 0; j < 4; ++j) v[r][j] = __builtin_nontemporal_load((const f32x4*)(xbase + (size_t)r * D) + lane + 64 * j);
#pragma unroll
        for (int r = 0; r < 4; ++r) {
            float s = 0.f;
            u32x2* o8 = (u32x2*)(XB + (size_t)(m4 + r) * D) + lane;
#pragma unroll
            for (int j = 0; j < 4; ++j) { s += (v[r][j][0] * v[r][j][0] + v[r][j][1] * v[r][j][1]) + (v[r][j][2] * v[r][j][2] + v[r][j][3] * v[r][j][3]);
                u32x2 w; w.x = pk2(v[r][j][0], v[r][j][1]); w.y = pk2(v[r][j][2], v[r][j][3]); o8[64 * j] = w; }
            s = wave_sum(s);
            if (lane < 4) *((f32x4*)(SSp + (size_t)(m4 + r) * 16) + lane) = (f32x4){lane == 0 ? s : 0.f, 0.f, 0.f, 0.f};
        }
    }
}

DI void lru_phase(PP pp, LAS unsigned char* lds, int tid, int lane, int wave) {
    const bf16_t* GR = (const bf16_t*)(pp->ws + WS_BIG);
    bf16_t* HG = (bf16_t*)(pp->ws + WS_BIG + (size_t)M * 2048 * 2);
    const bf16_t* WRT = (const bf16_t*)(pp->ws + WS_WRT); const bf16_t* WIT = (const bf16_t*)(pp->ws + WS_WIT);
    LAS unsigned char* sWr = lds; LAS unsigned char* sWi = lds + 9216; LAS unsigned char* sCb = lds + 18432;
    LAS float* sA = (LAS float*)(lds + 36864); LAS float* sB = (LAS float*)(lds + 69632);
    LAS float* segA = (LAS float*)(lds + 102400); LAS float* segB = (LAS float*)(lds + 104448);
    LAS float* carry = (LAS float*)(lds + 106496); LAS float* par = (LAS float*)(lds + 106752);
#if defined(PROBE_L2B)
    for (int unit_ = obid(); unit_ < 1536; unit_ += ogrid()) { const int unit = unit_ >= 768 ? unit_ - 768 : unit_;
#else
    for (int unit = obid(); unit < 768; unit += ogrid()) {
#endif
        const bool smp = unit >= 512; const int su = smp ? unit - 512 : unit; const int b = su >> 4, n = su & 15;
        const int m0 = smp ? MP + b * DT : b * T; const int TT = smp ? DT : T;
        float* out_h = pp->out + (smp ? O_SH : O_PH) + (size_t)b * D + n * 64;
        float* out_c = pp->out + (smp ? O_SC : O_PC) + (size_t)b * 3 * D + n * 64;
        const float* st_conv = pp->in[3] + (size_t)b * 3 * D + n * 64;
        if (tid < 64) {
            const int ch = n * 64 + tid;
#pragma unroll
            for (int k = 0; k < 4; ++k) par[k * 64 + tid] = pp->in[9][k * 1024 + ch];
            par[4 * 64 + tid] = pp->in[10][ch]; par[5 * 64 + tid] = pp->in[12][ch]; par[6 * 64 + tid] = pp->in[14][ch];
            const float lam = pp->in[15][ch];
            par[7 * 64 + tid] = 8.0f * (fminf(lam, 0.f) - log1pf(expf(-fabsf(lam))));
            carry[tid] = smp ? pp->in[2][(size_t)b * D + ch] : 0.f;
        }
        { const int row = tid >> 3, ck = tid & 7;
          *(LAS u32x4*)(sWr + row * 144 + ck * 16) = *(const u32x4*)(WRT + n * 4096 + row * 64 + ck * 8);
          *(LAS u32x4*)(sWi + row * 144 + ck * 16) = *(const u32x4*)(WIT + n * 4096 + row * 64 + ck * 8); }
        __syncthreads();
        const int nch = (TT + 127) >> 7;
        u32x4 xr[2][4], gtv[2];
#define LRU_LOAD_REC(t0_) do { _Pragma("unroll") for (int i = 0; i < 2; ++i) { const int item = tid + 512 * i, tl = item >> 3, gq = item & 7, t = (t0_) + tl; \
            _Pragma("unroll") for (int k = 0; k < 4; ++k) { const int tt = t - 3 + k; \
                if (t < TT && tt >= 0) xr[i][k] = *(const u32x4*)(GR + (size_t)(m0 + tt) * 2048 + 1024 + n * 64 + gq * 8); \
                else if (t < TT && smp) { const float* sp = st_conv + (size_t)(tt + 3) * D + gq * 8; const f32x4 a = *(const f32x4*)sp, bq = *(const f32x4*)(sp + 4); \
                    xr[i][k].x = pk2(a[0], a[1]); xr[i][k].y = pk2(a[2], a[3]); xr[i][k].z = pk2(bq[0], bq[1]); xr[i][k].w = pk2(bq[2], bq[3]); } \
                else xr[i][k] = (u32x4){0u, 0u, 0u, 0u}; } } } while (0)
        LRU_LOAD_REC(0);
        for (int ck = 0; ck < nch; ++ck) {
            const int t0 = ck << 7;
#pragma unroll
            for (int i = 0; i < 2; ++i) { const int item = tid + 512 * i, tl = item >> 3, gq = item & 7, t = t0 + tl;
                gtv[i] = (t < TT) ? *(const u32x4*)(GR + (size_t)(m0 + t) * 2048 + n * 64 + gq * 8) : (u32x4){0u, 0u, 0u, 0u}; }
#pragma unroll
            for (int i = 0; i < 2; ++i) {
                const int item = tid + 512 * i, tl = item >> 3, gq = item & 7, t = t0 + tl;
                float c[8];
                if (t < TT) {
                    float x3[8];
#pragma unroll
                    for (int e = 0; e < 8; ++e) c[e] = par[4 * 64 + gq * 8 + e];
#pragma unroll
                    for (int k = 0; k < 4; ++k) {
                        float xv[8]; unpack8(xr[i][k], xv);
#pragma unroll
                        for (int e = 0; e < 8; ++e) c[e] += par[k * 64 + gq * 8 + e] * xv[e];
                        if (k == 3) {
#pragma unroll
                            for (int e = 0; e < 8; ++e) x3[e] = xv[e]; }
                    }
                    if (t >= TT - 3) { float* o = out_c + (size_t)(t - (TT - 3)) * D + gq * 8;
                        *(f32x4*)o = (f32x4){x3[0], x3[1], x3[2], x3[3]}; *(f32x4*)(o + 4) = (f32x4){x3[4], x3[5], x3[6], x3[7]}; }
                } else {
#pragma unroll
                    for (int e = 0; e < 8; ++e) c[e] = 0.f;
                }
                *(LAS f32x4*)(sB + tl * 64 + gq * 8) = (f32x4){c[0], c[1], c[2], c[3]};
                *(LAS f32x4*)(sB + tl * 64 + gq * 8 + 4) = (f32x4){c[4], c[5], c[6], c[7]};
                *(LAS u32x4*)(sCb + tl * 144 + gq * 16) = pack8(c);
            }
            if (ck + 1 < nch) LRU_LOAD_REC(t0 + 128);
            __syncthreads();
            {
                const int l16 = lane & 15, q4 = lane >> 4;
                bf16x8 af[2];
#pragma unroll
                for (int ks = 0; ks < 2; ++ks) af[ks] = *(const LAS bf16x8*)(sCb + (16 * wave + l16) * 144 + (ks * 32 + q4 * 8) * 2);
#pragma unroll
                for (int nt = 0; nt < 4; ++nt) {
                    f32x4 ar = {0.f, 0.f, 0.f, 0.f}, ai = {0.f, 0.f, 0.f, 0.f};
#pragma unroll
                    for (int ks = 0; ks < 2; ++ks) {
                        const bf16x8 b1 = *(const LAS bf16x8*)(sWr + (16 * nt + l16) * 144 + (ks * 32 + q4 * 8) * 2);
                        const bf16x8 b2 = *(const LAS bf16x8*)(sWi + (16 * nt + l16) * 144 + (ks * 32 + q4 * 8) * 2);
                        ar = MFMA16(af[ks], b1, ar); ai = MFMA16(af[ks], b2, ai);
                    }
                    const int e = 16 * nt + l16; const float br_ = par[5 * 64 + e], bi_ = par[6 * 64 + e], cl = par[7 * 64 + e];
#pragma unroll
                    for (int j = 0; j < 4; ++j) {
                        const int tl = 16 * wave + 4 * q4 + j;
                        const float r = sigmoidf_(ar[j] + br_), ig = sigmoidf_(ai[j] + bi_), la = r * cl;
                        const float a = fexp2(la * LOG2E), x2 = 2.0f * la;
                        const float em_s = -x2 * (1.0f + x2 * (0.5f + x2 * (0.16666667f + x2 * (0.041666668f + x2 * 0.0083333338f)))), em_l = 1.0f - a * a;
                        const float bt = __builtin_amdgcn_sqrtf(x2 > -0.25f ? em_s : em_l) * ig * sB[tl * 64 + e];
                        sA[tl * 64 + e] = a; sB[tl * 64 + e] = bt;
                    }
                }
            }
            __syncthreads();
            {
                const int ch = tid & 63, seg = wave;
                float Aacc = 1.f, Bacc = 0.f;
#pragma unroll
                for (int k = 0; k < 16; ++k) { const int tl = 16 * seg + k; const float a = sA[tl * 64 + ch], bq = sB[tl * 64 + ch]; Bacc = a * Bacc + bq; Aacc *= a; }
                segA[seg * 64 + ch] = Aacc; segB[seg * 64 + ch] = Bacc;
                __syncthreads();
                float h = carry[ch];
                for (int s = 0; s < seg; ++s) h = segA[s * 64 + ch] * h + segB[s * 64 + ch];
#pragma unroll
                for (int k = 0; k < 16; ++k) { const int tl = 16 * seg + k; h = sA[tl * 64 + ch] * h + sB[tl * 64 + ch]; sB[tl * 64 + ch] = h; }
                __syncthreads();
                if (seg == 7) carry[ch] = h;
            }
#pragma unroll
            for (int i = 0; i < 2; ++i) {
                const int item = tid + 512 * i, tl = item >> 3, gq = item & 7, t = t0 + tl;
                if (t < TT) {
                    float g[8], o[8]; unpack8(gtv[i], g);
                    const f32x4 h0 = *(const LAS f32x4*)(sB + tl * 64 + gq * 8), h1 = *(const LAS f32x4*)(sB + tl * 64 + gq * 8 + 4);
                    const float h[8] = {h0[0], h0[1], h0[2], h0[3], h1[0], h1[1], h1[2], h1[3]};
#pragma unroll
                    for (int e = 0; e < 8; ++e) o[e] = h[e] * gelu_tanh(g[e]);
                    *(u32x4*)(HG + (size_t)(m0 + t) * 1024 + n * 64 + gq * 8) = pack8(o);
                    if (t == TT - 1) { *(f32x4*)(out_h + gq * 8) = h0; *(f32x4*)(out_h + gq * 8 + 4) = h1; }
                }
            }
            __syncthreads();
        }
    }
}

DI void ffn_fix_phase(PP pp, int layer, int tid) {
    bf16_t* H = (bf16_t*)(pp->ws + WS_BIG);
    const bf16_t* EG = (const bf16_t*)(pp->ws + WS_BIG + (size_t)M * 6144);
    const bf16_t* EU = EG + (size_t)(M / 16) * 4 * 3072;
    const float* cw = pp->in[26] + (size_t)layer * 3 * DFF; const float* cb = pp->in[27] + (size_t)layer * DFF;
    float* outp = pp->out;
    const int gt = obid() * 512 + tid, NT = ogrid() * 512;
    for (int it = gt; it < (M / 16) * 384; it += NT) {
        const int grp = it / 384, j0 = (it - grp * 384) * 8;
        const bool smp = grp >= MP / 16; int b, t0;
        if (!smp) { b = grp >> 7; t0 = (grp & 127) << 4; } else { b = grp - MP / 16; t0 = 0; }
        const u32x4 e0 = *(const u32x4*)(EG + ((size_t)grp * 4 + 0) * 3072 + j0), e1 = *(const u32x4*)(EG + ((size_t)grp * 4 + 1) * 3072 + j0),
                    e2 = *(const u32x4*)(EG + ((size_t)grp * 4 + 2) * 3072 + j0), e3 = *(const u32x4*)(EG + ((size_t)grp * 4 + 3) * 3072 + j0),
                    q0 = *(const u32x4*)(EU + ((size_t)grp * 2 + 0) * 3072 + j0), q1 = *(const u32x4*)(EU + ((size_t)grp * 2 + 1) * 3072 + j0);
        float w0[8], w1[8], w2[8], bb[8], gm2[8], gm1[8], g0[8], g1[8], u0[8], u1[8], h0[8], h1[8];
        { const f32x4 a = *(const f32x4*)(cw + j0), a2 = *(const f32x4*)(cw + j0 + 4), b1 = *(const f32x4*)(cw + DFF + j0), b2 = *(const f32x4*)(cw + DFF + j0 + 4),
                      c1 = *(const f32x4*)(cw + 2 * DFF + j0), c2 = *(const f32x4*)(cw + 2 * DFF + j0 + 4), d1 = *(const f32x4*)(cb + j0), d2 = *(const f32x4*)(cb + j0 + 4);
#pragma unroll
          for (int e = 0; e < 4; ++e) { w0[e] = a[e]; w0[e + 4] = a2[e]; w1[e] = b1[e]; w1[e + 4] = b2[e]; w2[e] = c1[e]; w2[e + 4] = c2[e]; bb[e] = d1[e]; bb[e + 4] = d2[e]; } }
        if (t0 > 0) { unpack8(*(const u32x4*)(EG + ((size_t)(grp - 1) * 4 + 0) * 3072 + j0), gm2); unpack8(*(const u32x4*)(EG + ((size_t)(grp - 1) * 4 + 1) * 3072 + j0), gm1); }
        else if (smp) { const float* sp = pp->in[4] + (size_t)(layer * DB + b) * 2 * DFF + j0;
            const f32x4 a = *(const f32x4*)sp, a2 = *(const f32x4*)(sp + 4), c1 = *(const f32x4*)(sp + DFF), c2 = *(const f32x4*)(sp + DFF + 4);
#pragma unroll
            for (int e = 0; e < 4; ++e) { gm2[e] = a[e]; gm2[e + 4] = a2[e]; gm1[e] = c1[e]; gm1[e + 4] = c2[e]; } }
        else {
#pragma unroll
            for (int e = 0; e < 8; ++e) { gm1[e] = 0.f; gm2[e] = 0.f; } }
        unpack8(e2, g0); unpack8(e3, g1); unpack8(q0, u0); unpack8(q1, u1);
#pragma unroll
        for (int e = 0; e < 8; ++e) {
            h0[e] = gelu_tanh(bb[e] + w0[e] * gm2[e] + w1[e] * gm1[e] + w2[e] * g0[e]) * u0[e];
            h1[e] = gelu_tanh(bb[e] + w0[e] * gm1[e] + w1[e] * g0[e] + w2[e] * g1[e]) * u1[e];
        }
        *(u32x4*)(H + (size_t)grp * 16 * 3072 + j0) = pack8(h0);
        *(u32x4*)(H + ((size_t)grp * 16 + 1) * 3072 + j0) = pack8(h1);
        if (smp || t0 == T - 16) {
            float* o = outp + (smp ? O_SF + (size_t)(layer * DB + b) * 2 * DFF : O_PF + (size_t)(layer * NB + b) * 2 * DFF) + j0;
            float s0[8], s1[8]; unpack8(e0, s0); unpack8(e1, s1);
            *(f32x4*)o = (f32x4){s0[0], s0[1], s0[2], s0[3]}; *(f32x4*)(o + 4) = (f32x4){s0[4], s0[5], s0[6], s0[7]};
            *(f32x4*)(o + DFF) = (f32x4){s1[0], s1[1], s1[2], s1[3]}; *(f32x4*)(o + DFF + 4) = (f32x4){s1[4], s1[5], s1[6], s1[7]};
        }
    }
}

DI void headnorm_phase(PP pp, int lane, int wave) {
    bf16_t* QKV = (bf16_t*)(pp->ws + WS_BIG);
    const float* kn = pp->in[19]; const float* qn = pp->in[22];
    const int gw = obid() * 8 + wave, NGW = ogrid() * 8;
    float* outp = pp->out;
    f32x4 kg[2][2], qg[2][2];
#pragma unroll
    for (int it = 0; it < 2; ++it) { const int d0 = ((it * 64 + lane) * 8) & 127;
        kg[it][0] = *(const f32x4*)(kn + d0); kg[it][1] = *(const f32x4*)(kn + d0 + 4); qg[it][0] = *(const f32x4*)(qn + d0) * QSCALE; qg[it][1] = *(const f32x4*)(qn + d0 + 4) * QSCALE; }
    for (int m2 = gw * 2; m2 < M; m2 += NGW * 2) {
        u32x4 kr[2][2], vr[2][2], qr[2][2];
#pragma unroll
        for (int r = 0; r < 2; ++r)
#pragma unroll
            for (int it = 0; it < 2; ++it) { const bf16_t* rp = QKV + (size_t)(m2 + r) * 3072 + (it * 64 + lane) * 8;
                kr[r][it] = *(const u32x4*)rp; vr[r][it] = *(const u32x4*)(rp + 1024); qr[r][it] = *(const u32x4*)(rp + 2048); }
#pragma unroll
        for (int r = 0; r < 2; ++r) {
            const int m = m2 + r;
            bf16_t* row = QKV + (size_t)m * 3072;
            float* ok = m < MP ? outp + O_PK + (size_t)m * D : outp + O_SK + (size_t)(m - MP) * D;
            float* ov = m < MP ? outp + O_PV + (size_t)m * D : outp + O_SV + (size_t)(m - MP) * D;
#pragma unroll
            for (int it = 0; it < 2; ++it) {
                const int col = (it * 64 + lane) * 8;
                float f[8]; float s;
                unpack8(kr[r][it], f); s = 0.f;
#pragma unroll
                for (int e = 0; e < 8; ++e) s += f[e] * f[e];
                s += __shfl_xor(s, 1); s += __shfl_xor(s, 2); s += __shfl_xor(s, 4); s += __shfl_xor(s, 8);
                float rs = __builtin_amdgcn_rsqf(s * (1.f / 128.f) + EPS);
#pragma unroll
                for (int e = 0; e < 4; ++e) { f[e] = f[e] * rs * kg[it][0][e]; f[e + 4] = f[e + 4] * rs * kg[it][1][e]; }
                *(f32x4*)(ok + col) = (f32x4){f[0], f[1], f[2], f[3]}; *(f32x4*)(ok + col + 4) = (f32x4){f[4], f[5], f[6], f[7]};
                *(u32x4*)(row + col) = pack8(f);
                unpack8(vr[r][it], f);
                *(f32x4*)(ov + col) = (f32x4){f[0], f[1], f[2], f[3]}; *(f32x4*)(ov + col + 4) = (f32x4){f[4], f[5], f[6], f[7]};
                unpack8(qr[r][it], f); s = 0.f;
#pragma unroll
                for (int e = 0; e < 8; ++e) s += f[e] * f[e];
                s += __shfl_xor(s, 1); s += __shfl_xor(s, 2); s += __shfl_xor(s, 4); s += __shfl_xor(s, 8);
                rs = __builtin_amdgcn_rsqf(s * (1.f / 128.f) + EPS);
#pragma unroll
                for (int e = 0; e < 4; ++e) { f[e] = f[e] * rs * qg[it][0][e]; f[e + 4] = f[e + 4] * rs * qg[it][1][e]; }
                *(u32x4*)(row + 2048 + col) = pack8(f);
            }
        }
    }
}

constexpr int AT_KP = 272, AT_VP = 136, AT_KB = 64 * AT_KP, AT_VB = 128 * AT_VP, AT_BUF = AT_KB + AT_VB, AT_FLAGS = 2 * AT_BUF;
template <bool SMP>
DI void attn_unit(PP pp, LAS unsigned char* lds, int tid, int lane, int wave, int b, int h, int qb) {
    const bf16_t* QKV = (const bf16_t*)(pp->ws + WS_BIG);
    bf16_t* AO = (bf16_t*)(pp->ws + WS_BIG + (size_t)M * 3072 * 2);
    const int mrow0 = SMP ? MP + b * DT : b * T;
    const int qpos0 = SMP ? PAST : qb * 256;
    const int qrow0 = SMP ? mrow0 : mrow0 + qb * 256;
    const int nq = SMP ? DT : 256;
    const int ntiles = SMP ? (PAST + DT - 2) / 64 + 1 : 4 * qb + 4;
    const int q = lane & 31, hl = lane >> 5, wq0 = 32 * wave;
    const int vhx = 8 * hl;
    const bool wave_valid = wq0 < nq;
    const int myq = wq0 + q; const bool qvalid = myq < nq; const int qpos = qpos0 + myq; const int p_lo = qpos0 + wq0;
    LAS unsigned* sAlive = (LAS unsigned*)(lds + AT_FLAGS);
    bf16x8 qf[8];
    { const bf16_t* qp = QKV + (size_t)(qrow0 + (qvalid ? myq : 0)) * 3072 + 2048 + h * 128 + hl * 8;
#pragma unroll
      for (int s = 0; s < 8; ++s) qf[s] = *(const bf16x8*)(qp + s * 16); }
    f32x16 O[4];
#pragma unroll
    for (int dt = 0; dt < 4; ++dt)
#pragma unroll
        for (int j = 0; j < 16; ++j) O[dt][j] = 0.f;
    float R = 1.f; int wlive = 1;
    const float* ck = pp->in[5]; const float* cv = pp->in[6];
    u32x4 kr[2], vr[2];
#define AT_LOAD(kt_) do { if (!SMP) { _Pragma("unroll") for (int i = 0; i < 2; ++i) { const int c = tid + 512 * i, kl = c >> 4, part = c & 15, s = 64 * (kt_) + kl; \
        const bf16_t* rp = QKV + (size_t)(mrow0 + s) * 3072 + h * 128 + part * 8; kr[i] = *(const u32x4*)rp; vr[i] = *(const u32x4*)(rp + 1024); } } } while (0)
#define AT_STORE(buf_, kt_) do { LAS unsigned char* sK_ = lds + (buf_) * AT_BUF; LAS unsigned char* sV_ = sK_ + AT_KB; \
        _Pragma("unroll") for (int i = 0; i < 2; ++i) { const int c = tid + 512 * i, kl = c >> 4, part = c & 15; u32x4 kk, vv; \
            if (!SMP) { kk = kr[i]; vv = vr[i]; } \
            else { const int s = 64 * (kt_) + kl; \
                if (s < PAST) { const size_t off = (((size_t)b * PAST + s) * NH + h) * HD + part * 8; \
                    const f32x4 k0 = *(const f32x4*)(ck + off), k1 = *(const f32x4*)(ck + off + 4), v0 = *(const f32x4*)(cv + off), v1 = *(const f32x4*)(cv + off + 4); \
                    kk.x = pk2(k0[0], k0[1]); kk.y = pk2(k0[2], k0[3]); kk.z = pk2(k1[0], k1[1]); kk.w = pk2(k1[2], k1[3]); \
                    vv.x = pk2(v0[0], v0[1]); vv.y = pk2(v0[2], v0[3]); vv.z = pk2(v1[0], v1[1]); vv.w = pk2(v1[2], v1[3]); } \
                else if (s < PAST + DT) { const bf16_t* rp = QKV + (size_t)(mrow0 + s - PAST) * 3072 + h * 128 + part * 8; kk = *(const u32x4*)rp; vv = *(const u32x4*)(rp + 1024); } \
                else { kk = (u32x4){0u, 0u, 0u, 0u}; vv = kk; } } \
            *(LAS u32x4*)(sK_ + kl * AT_KP + part * 16) = kk; \
            LAS unsigned short* vp = (LAS unsigned short*)(sV_ + (part * 8) * AT_VP + (kl ^ (4 * (part >> 2))) * 2);     \
            vp[0 * (AT_VP / 2)] = (unsigned short)(vv.x & 0xffffu); vp[1 * (AT_VP / 2)] = (unsigned short)(vv.x >> 16); \
            vp[2 * (AT_VP / 2)] = (unsigned short)(vv.y & 0xffffu); vp[3 * (AT_VP / 2)] = (unsigned short)(vv.y >> 16); \
            vp[4 * (AT_VP / 2)] = (unsigned short)(vv.z & 0xffffu); vp[5 * (AT_VP / 2)] = (unsigned short)(vv.z >> 16); \
            vp[6 * (AT_VP / 2)] = (unsigned short)(vv.w & 0xffffu); vp[7 * (AT_VP / 2)] = (unsigned short)(vv.w >> 16); } } while (0)

    AT_LOAD(ntiles - 1); AT_STORE(0, ntiles - 1);
    __syncthreads();
    int it = 0;
    for (int kt = ntiles - 1; kt >= 0; --kt, ++it) {
        if (kt > 0) AT_LOAD(kt - 1);
        const LAS unsigned char* sK = lds + (it & 1) * AT_BUF; const LAS unsigned char* sVt = sK + AT_KB;
        if (wave_valid && wlive) {
#pragma unroll
            for (int sub = 1; sub >= 0; --sub) {
                const int kbase = 64 * kt + 32 * sub;
                if (kbase <= p_lo + 30) {
                    f32x16 S;
#pragma unroll
                    for (int j = 0; j < 16; ++j) S[j] = 0.f;
#pragma unroll
                    for (int s = 0; s < 8; ++s) { const bf16x8 kf = *(const LAS bf16x8*)(sK + (32 * sub + q) * AT_KP + s * 32 + hl * 16); S = MFMA32(kf, qf[s], S); }
                    float sg[16];
                    if (kbase + 31 >= p_lo) {
#pragma unroll
                        for (int j = 0; j < 16; ++j) {
                            const int key = kbase + 8 * (j >> 2) + 4 * hl + (j & 3);
                            const float v = frcp(1.0f + fexp2(S[j]));
                            sg[j] = key >= qpos ? 1.0f : v;
                        }
                    } else {
#pragma unroll
                        for (int j = 0; j < 16; ++j) sg[j] = frcp(1.0f + fexp2(S[j]));
                    }
                    float Gq[4], pr[4], Tg[4];
#pragma unroll
                    for (int g = 0; g < 4; ++g) { const float gp = (sg[4 * g] * sg[4 * g + 1]) * (sg[4 * g + 2] * sg[4 * g + 3]); Gq[g] = __shfl_xor(gp, 32); pr[g] = gp * Gq[g]; }
                    Tg[3] = 1.f; Tg[2] = pr[3]; Tg[1] = pr[3] * pr[2]; Tg[0] = Tg[1] * pr[1];
                    float w[16];
#pragma unroll
                    for (int g = 0; g < 4; ++g) {
                        float P = R * Tg[g]; if (hl == 0) P *= Gq[g];
                        w[4 * g + 3] = (1.0f - sg[4 * g + 3]) * P; P *= sg[4 * g + 3];
                        w[4 * g + 2] = (1.0f - sg[4 * g + 2]) * P; P *= sg[4 * g + 2];
                        w[4 * g + 1] = (1.0f - sg[4 * g + 1]) * P; P *= sg[4 * g + 1];
                        w[4 * g] = (1.0f - sg[4 * g]) * P;
                    }
                    R = R * Tg[0] * pr[0];
#pragma unroll
                    for (int ks = 0; ks < 2; ++ks) {
                        u32x4 wp; wp.x = pk2(w[8 * ks], w[8 * ks + 1]); wp.y = pk2(w[8 * ks + 2], w[8 * ks + 3]); wp.z = pk2(w[8 * ks + 4], w[8 * ks + 5]); wp.w = pk2(w[8 * ks + 6], w[8 * ks + 7]);
                        const bf16x8 wf = __builtin_bit_cast(bf16x8, wp);
#pragma unroll
                        for (int dt = 0; dt < 4; ++dt) {
                            const LAS unsigned char* vrp = sVt + (32 * dt + q) * AT_VP + ((dt & 1) ? 8 - vhx : vhx);
                            const u32x2 v0 = *(const LAS u32x2*)(vrp + ((32 * sub + 16 * ks) ^ (8 * (dt >> 1))) * 2), v1 = *(const LAS u32x2*)(vrp + ((32 * sub + 16 * ks + 8) ^ (8 * (dt >> 1))) * 2);
                            const u32x4 vv = {v0.x, v0.y, v1.x, v1.y};
                            O[dt] = MFMA32(__builtin_bit_cast(bf16x8, vv), wf, O[dt]);
                        }
                    }
                }
            }
        }
        {
            const bool started = wave_valid && (64 * kt <= p_lo + 30);
            const unsigned long long bal = __ballot(qvalid && R != 0.f);
            const unsigned alive = wave_valid ? ((!started || bal != 0ull) ? 1u : 0u) : 0u;
            wlive = __builtin_amdgcn_readfirstlane((int)alive);
            if (lane == 0) sAlive[(it & 1) * 8 + wave] = alive;
        }
        if (kt > 0) AT_STORE((it + 1) & 1, kt - 1);
        __syncthreads();
        unsigned any = 0;
#pragma unroll
        for (int w8 = 0; w8 < 8; ++w8) any |= sAlive[(it & 1) * 8 + w8];
        if (!any) break;
    }
#undef AT_LOAD
#undef AT_STORE
    if (wave_valid && qvalid) {
        bf16_t* orow = AO + (size_t)(qrow0 + myq) * 1024 + h * 128 + 4 * hl;
#pragma unroll
        for (int dt = 0; dt < 4; ++dt)
#pragma unroll
            for (int g = 0; g < 4; ++g) { u32x2 w; w.x = pk2(O[dt][4 * g], O[dt][4 * g + 1]); w.y = pk2(O[dt][4 * g + 2], O[dt][4 * g + 3]); *(u32x2*)(orow + 32 * dt + 8 * g) = w; }
    }
}
DI void attn_phase(PP pp, LAS unsigned char* lds, int tid, int lane, int wave) {
    for (int u = obid(); u < 128 + 2048; u += ogrid()) {
        if (u < 128) attn_unit<true>(pp, lds, tid, lane, wave, u >> 3, u & 7, 0);
        else { const int v = u - 128, qb = 7 - (v >> 8), rem = v & 255; attn_unit<false>(pp, lds, tid, lane, wave, rem >> 3, rem & 7, qb); }
        __syncthreads();
    }
}

DI void final_phase(PP pp, int lane, int wave) {
    const int gw = obid() * 8 + wave, NGW = ogrid() * 8; const float* gn = pp->in[29];
    const bf16_t* XB = (const bf16_t*)(pp->ws + WS_XB);
    f32x4 gv[4];
#pragma unroll
    for (int j = 0; j < 4; ++j) gv[j] = *((const f32x4*)gn + lane + 64 * j);
    float* outp = pp->out;
    for (int m4 = gw * 4; m4 < M; m4 += NGW * 4) {
        u32x2 raw[4][4];
#pragma unroll
        for (int r = 0; r < 4; ++r)
#pragma unroll
            for (int j = 0; j < 4; ++j) raw[r][j] = __builtin_nontemporal_load((const u32x2*)(XB + (size_t)(m4 + r) * D) + lane + 64 * j);
#pragma unroll
        for (int r = 0; r < 4; ++r) {
            f32x4 v[4]; float s = 0.f;
#pragma unroll
            for (int j = 0; j < 4; ++j) { v[j] = (f32x4){bflo(raw[r][j].x), bfhi(raw[r][j].x), bflo(raw[r][j].y), bfhi(raw[r][j].y)};
                s += (v[j][0] * v[j][0] + v[j][1] * v[j][1]) + (v[j][2] * v[j][2] + v[j][3] * v[j][3]); }
            const float rstd = __builtin_amdgcn_rsqf(wave_sum(s) * (1.f / D) + EPS);
#pragma unroll
            for (int j = 0; j < 4; ++j) *((f32x4*)(outp + (size_t)(m4 + r) * D) + lane + 64 * j) = v[j] * rstd * gv[j];
        }
    }
}

#define XB_TMO      128
#define XB_XCNT(j)  (256  + 64 * (j))
#define XB_XSUB(j)  (1280 + 64 * (j))
#define XB_XGEN(j)  (2304 + 64 * (j))
#define XB_TOP      3328
#define XB_TOPGEN   3392
#define XCD_BAR_WORDS 3456
#define XB_SPIN_CAP (1u << 18)

__device__ __forceinline__ unsigned xb_ld(unsigned* p)              { return __hip_atomic_load(p, __ATOMIC_RELAXED, __HIP_MEMORY_SCOPE_AGENT); }
__device__ __forceinline__ unsigned xb_add(unsigned* p, unsigned v) { return __hip_atomic_fetch_add(p, v, __ATOMIC_RELAXED, __HIP_MEMORY_SCOPE_AGENT); }
__device__ __forceinline__ unsigned xb_xcc_id() { return (unsigned)__builtin_amdgcn_s_getreg((3 << 11) | 20) & 0xFu; }
#define XB_SPIN(cond, bar) do { unsigned _sp = 0; while (cond) { __builtin_amdgcn_s_sleep(1); \
    if ((++_sp & 255u) == 0u) { if (xb_ld(&(bar)[XB_TMO])) break; if (_sp > XB_SPIN_CAP) { atomicAdd(&(bar)[XB_TMO], 1u); break; } } } } while (0)

struct XcdBarrier {
    unsigned* bar; unsigned x;
    volatile LAS unsigned* st;
};

__device__ __forceinline__ XcdBarrier xcd_barrier_post(unsigned* bar, volatile LAS unsigned* st) {
    XcdBarrier b; b.bar = bar; b.x = xb_xcc_id(); b.st = st;
    if (threadIdx.x == 0) (void)xb_add(&bar[XB_XCNT(b.x)], 1u);
    return b;
}
__device__ __forceinline__ void xcd_barrier_complete(unsigned* bar, unsigned x, unsigned& nloc, unsigned& nx) {
    const unsigned G = gridDim.x * gridDim.y * gridDim.z;
    unsigned sum, cnt, mine, sp = 0u;
    for (;;) {
        sum = 0u; cnt = 0u; mine = 0u;
#pragma unroll
        for (unsigned j = 0; j < 16; ++j) { const unsigned c = xb_ld(&bar[XB_XCNT(j)]); sum += c; cnt += (c > 0u) ? 1u : 0u; mine = (j == x) ? c : mine; }
        if (sum == G) break;
        __builtin_amdgcn_s_sleep(1);
        if ((++sp & 255u) == 0u) { if (xb_ld(&bar[XB_TMO])) break; if (sp > XB_SPIN_CAP) { atomicAdd(&bar[XB_TMO], 1u); break; } }
    }
    nloc = mine > 0u ? mine : 1u; nx = cnt > 0u ? cnt : 1u;
}

__device__ __forceinline__ void xcd_barrier(const XcdBarrier& b) {
    asm volatile("s_waitcnt vmcnt(0)" ::: "memory");
    __syncthreads();
    if (threadIdx.x == 0) {
        unsigned* bar = b.bar;
        __builtin_amdgcn_s_waitcnt(0);
        unsigned nloc = b.st[0], nx = b.st[1];
        if (nloc == 0u) { xcd_barrier_complete(bar, b.x, nloc, nx); b.st[0] = nloc; b.st[1] = nx; }
        const unsigned old = xb_add(&bar[XB_XSUB(b.x)], 1u);
        const unsigned gen = old / nloc;
        if (old + 1u == (gen + 1u) * nloc) {
            __builtin_amdgcn_fence(__ATOMIC_RELEASE, "agent");
            asm volatile("s_waitcnt vmcnt(0)" ::: "memory");
            const unsigned og = xb_add(&bar[XB_TOP], 1u);
            const unsigned tg = og / nx;
            if (og + 1u == (tg + 1u) * nx) xb_add(&bar[XB_TOPGEN], 1u);
            else XB_SPIN(xb_ld(&bar[XB_TOPGEN]) == tg, bar);
            __builtin_amdgcn_fence(__ATOMIC_ACQUIRE, "agent");
            xb_add(&bar[XB_XGEN(b.x)], 1u);
            asm volatile("s_waitcnt vmcnt(0)" ::: "memory");
        } else {
            XB_SPIN(xb_ld(&bar[XB_XGEN(b.x)]) == gen, bar);
            __builtin_amdgcn_fence(__ATOMIC_ACQUIRE, "agent");
            asm volatile("s_waitcnt vmcnt(0)" ::: "memory");
        }
    }
    __syncthreads();
}

__global__ void __launch_bounds__(512, 2) fwd_kernel(Params p) {
    extern __shared__ __attribute__((aligned(16))) unsigned char lds_raw[];
    LAS unsigned char* lds = (LAS unsigned char*)lds_raw;
    cg::grid_group grid = cg::this_grid();
    constexpr int LDS_ST = 143360;
    { const int t0_ = otid(); if (t0_ < 2) ((LAS unsigned*)(lds + LDS_ST))[t0_] = 0u; __syncthreads();
      PP pp0 = (PP)__builtin_amdgcn_kernarg_segment_ptr(); (void)xcd_barrier_post((unsigned*)(pp0->ws + WS_CW), (volatile LAS unsigned*)(lds + LDS_ST)); }
#pragma unroll 1
    for (int ph = 0; ph < 15; ++ph) {
        if (ph == 8) continue;
        const int tid = otid(), lane = tid & 63, wave = __builtin_amdgcn_readfirstlane(tid >> 6), bid = obid(), nblk = ogrid();
        PP pp = (PP)__builtin_amdgcn_kernarg_segment_ptr();
        asm volatile("" : "+s"(pp));
        unsigned char* ws = pp->ws;
        bf16_t* XB = (bf16_t*)(ws + WS_XB); float* SS = (float*)(ws + WS_SS); bf16_t* BIG = (bf16_t*)(ws + WS_BIG);
        float* X = pp->out;
        if (ph == 4 || ph == 11) {
            const int layer = ph == 4 ? 0 : 1;
            const bf16_t* Bt = (const bf16_t*)(ws + (layer ? WS_WUP1 : WS_WUP0));
            pg8::Gemm g{XB, Bt, M, 6144, 1024, 1024}; pg8::StaticOrder S; S.init(M, 6144, nblk, bid);
            bf16_t* EGp = BIG + (size_t)M * 3072;
            pg8::EpiFfn E{BIG, EGp, EGp + (size_t)(M / 16) * 4 * 3072, SS, pp->in[26] + (size_t)layer * 3 * DFF, pp->in[27] + (size_t)layer * DFF};
            pg8::gemm_phase<pg8::EpiFfn, pg8::StaticOrder, true, true>(lds, g, S, E);
        } else if (ph == 7) {
            pg8::Gemm g{XB, (const bf16_t*)(ws + WS_WQKV), M, 3072, 1024, 1024}; pg8::StaticOrder S; S.init(M, 3072, nblk, bid);
            pg8::EpiQkv E{BIG, X, SS, pp->in[19], pp->in[22], (LAS float*)(lds + 131072), O_PK, O_PV, O_SK, O_SV, MP, QSCALE};
            pg8::gemm_phase<pg8::EpiQkv, pg8::StaticOrder, true, true>(lds, g, S, E);
        } else if (ph == 1) {
            const bf16_t* Bt; int N; const float* ss = SS;
            { Bt = (const bf16_t*)(ws + WS_WIN); N = 2048; }
            pg8::Gemm g{XB, Bt, M, N, 1024, 1024}; pg8::StaticOrder S; S.init(M, N, nblk, bid);
            pg8::EpiScaleBf16 E{BIG, N, ss};
#if !defined(NO_GS)
            pg8::gemm_phase<pg8::EpiScaleBf16, pg8::StaticOrder, true, true>(lds, g, S, E);
#endif
#if defined(PROBE_GS2)
            grid.sync(); pg8::gemm_phase<pg8::EpiScaleBf16, pg8::StaticOrder, true, true>(lds, g, S, E);
#endif
        } else if (ph == 3 || ph == 6 || ph == 10 || ph == 13) {
            const bf16_t* A; const bf16_t* Bt; int K, lda;
            if (ph == 3) { A = BIG + (size_t)M * 2048; lda = 1024; K = 1024; Bt = (const bf16_t*)(ws + WS_WOUT); }
            else if (ph == 6) { A = BIG; lda = 3072; K = 3072; Bt = (const bf16_t*)(ws + WS_WDN0); }
            else if (ph == 10) { A = BIG + (size_t)M * 3072; lda = 1024; K = 1024; Bt = (const bf16_t*)(ws + WS_WO); }
            else { A = BIG; lda = 3072; K = 3072; Bt = (const bf16_t*)(ws + WS_WDN1); }
            pg8::Gemm g{A, Bt, M, 1024, K, lda}; pg8::StaticOrder S; S.init(M, 1024, nblk, bid);
            pg8::EpiResid E{XB, SS};
#if !defined(NO_GR)
            pg8::gemm_phase<pg8::EpiResid, pg8::StaticOrder, true, true>(lds, g, S, E);
#endif
        }
#if !defined(NO_P0)
        else if (ph == 0) phase0(pp, lds, lane, wave);
#endif
#if !defined(NO_LRU)
        else if (ph == 2) {
#if defined(PROBE_L2)
            _Pragma("unroll 1") for (int rep = 0; rep < 2; ++rep) { if (rep) grid.sync(); lru_phase(pp, lds, tid, lane, wave); }
#else
            lru_phase(pp, lds, tid, lane, wave);
#endif
        }
#endif
#if !defined(NO_ACT)
        else if (ph == 5 || ph == 12) ffn_fix_phase(pp, ph == 5 ? 0 : 1, tid);
#endif
#if !defined(NO_HN)
        else if (ph == 8) headnorm_phase(pp, lane, wave);
#endif
#if !defined(NO_ATT)
        else if (ph == 9) {
#if defined(PROBE_A2)
            _Pragma("unroll 1") for (int rep = 0; rep < 2; ++rep) { if (rep) grid.sync(); attn_phase(pp, lds, tid, lane, wave); }
#else
            attn_phase(pp, lds, tid, lane, wave);
#endif
        }
#endif
#if !defined(NO_FIN)
        else if (ph == 14) final_phase(pp, lane, wave);
#endif
        if (ph == 0) grid.sync();
        else if (ph < 14) { XcdBarrier xb; xb.bar = (unsigned*)(ws + WS_CW); xb.x = xb_xcc_id(); xb.st = (volatile LAS unsigned*)(lds + LDS_ST); xcd_barrier(xb); }
    }
}

extern "C" void kernel_launch(void* const* d_in, const int* in_sizes, int n_in, void* d_out, int out_size, void* d_ws, size_t ws_size, hipStream_t stream) {
    static int grid = 0;
    if (grid == 0) {
        if (n_in != 30 || (size_t)out_size != O_END || ws_size < WS_END) { fprintf(stderr, "kernel_launch: unexpected shapes n_in %d out %d ws %zu (need %zu)\n", n_in, out_size, ws_size, (size_t)WS_END); grid = -1; return; }
        int dev = 0, cus = 0, per_cu = 0;
        hipGetDevice(&dev); hipDeviceGetAttribute(&cus, hipDeviceAttributeMultiprocessorCount, dev);
        if (hipFuncSetAttribute((const void*)fwd_kernel, hipFuncAttributeMaxDynamicSharedMemorySize, LDS_BYTES) != hipSuccess) { fprintf(stderr, "kernel_launch: hipFuncSetAttribute failed\n"); grid = -1; return; }
        if (hipOccupancyMaxActiveBlocksPerMultiprocessor(&per_cu, (const void*)fwd_kernel, 512, LDS_BYTES) != hipSuccess || per_cu < 1) { fprintf(stderr, "kernel_launch: occupancy query failed (%d)\n", per_cu); per_cu = 1; }
        (void)hipGetLastError();
        grid = cus * per_cu;
    }
    if (grid < 0) return;
    if (hipMemsetAsync((char*)d_ws + WS_CW, 0, CW_BYTES, stream) != hipSuccess) { fprintf(stderr, "kernel_launch: memset of the barrier words failed\n"); return; }
    Params p{};
    for (int i = 0; i < 30; ++i) p.in[i] = (const float*)d_in[i];
    p.out = (float*)d_out; p.ws = (unsigned char*)d_ws;
    void* args[] = {&p};
    hipError_t e = hipLaunchCooperativeKernel((const void*)fwd_kernel, dim3(grid), dim3(512), args, LDS_BYTES, stream);
    if (e != hipSuccess) fprintf(stderr, "cooperative launch failed: %s (grid %d)\n", hipGetErrorString(e), grid);
}
```
